# Optimizing an MI355X kernel written in HIP

```python
import numpy as np
import jax
import jax.numpy as jnp
from jax import lax

D_MODEL = 1024
BATCH = 16
SEQ = 2048
DEPTH = 2

HEAD_DIM = 64
GLA_HEADS = 4
GLA_WIDTH = GLA_HEADS * HEAD_DIM
GLA_GATE_RANK = 16
GLA_TAU = 16.0
GLA_CHUNK = 64
RWKV_HEADS = 4
RWKV_WIDTH = RWKV_HEADS * HEAD_DIM
RWKV_DECAY_RANK = 64
RWKV_ICLR_RANK = 64
RWKV_VRES_RANK = 32
RWKV_GATE_RANK = 160
RWKV_GN_EPS = 64e-5
NSA_HEADS = 8
NSA_KV_HEADS = 2
NSA_WIDTH = NSA_HEADS * HEAD_DIM
NSA_KV_WIDTH = NSA_KV_HEADS * HEAD_DIM
NSA_CMP_BLOCK = 32
NSA_CMP_STRIDE = 16
NSA_CMP_HIDDEN = 256
NSA_SEL_BLOCK = 64
NSA_N_SELECT = 16
NSA_WINDOW = 512
NSA_SEL_QCHUNK = 32
NSA_WIN_QBLOCK = 128
ROPE_THETA = 10000.0
FFN_HIDDEN = ((8 * D_MODEL + 3 * 256 - 1) // (3 * 256)) * 256
DEEPNORM_ALPHA = (2 * DEPTH) ** 0.25
DEEPNORM_BETA = (8 * DEPTH) ** -0.25
LN_EPS = 1e-5
MASK_NEG = -1e30

GLA_COLS = (GLA_WIDTH, GLA_WIDTH, GLA_WIDTH, GLA_WIDTH, GLA_GATE_RANK)
RWKV_COLS = (RWKV_WIDTH, RWKV_WIDTH, RWKV_WIDTH,
             RWKV_DECAY_RANK, RWKV_ICLR_RANK, RWKV_GATE_RANK)
NSA_COLS = (NSA_WIDTH,) + (NSA_KV_WIDTH,) * 6 + (3 * NSA_HEADS,)
IN_COLS = sum(GLA_COLS) + sum(RWKV_COLS) + sum(NSA_COLS)

kernel_name = 'hybrid_gla_rwkv7_nsa_deepnorm'


def _split(h, widths):
    idx = np.cumsum(np.asarray(widths))[:-1].tolist()
    return jnp.split(h, idx, axis=-1)


def _layer_norm(x, w, b):
    xf = x.astype(jnp.float32)
    mu = xf.mean(-1, keepdims=True)
    var = jnp.square(xf - mu).mean(-1, keepdims=True)
    return ((xf - mu) * lax.rsqrt(var + LN_EPS) * w + b).astype(x.dtype)


def _head_norm(x, w, b, n_heads, eps):
    shp = x.shape
    xh = x.astype(jnp.float32).reshape(shp[:-1] + (n_heads, shp[-1] // n_heads))
    mu = xh.mean(-1, keepdims=True)
    var = jnp.square(xh - mu).mean(-1, keepdims=True)
    xh = (xh - mu) * lax.rsqrt(var + eps)
    return xh.reshape(shp) * w + b


def _rope(x, pos):
    half = x.shape[-1] // 2
    inv = ROPE_THETA ** (-jnp.arange(half, dtype=jnp.float32) / half)
    ang = pos.astype(jnp.float32)[:, None] * inv
    shape = (ang.shape[0],) + (1,) * (x.ndim - 3) + (half,)
    cos = jnp.cos(ang).reshape(shape).astype(x.dtype)
    sin = jnp.sin(ang).reshape(shape).astype(x.dtype)
    x1, x2 = x[..., :half], x[..., half:]
    return jnp.concatenate([x1 * cos - x2 * sin, x1 * sin + x2 * cos], axis=-1)


def _token_shift_mix(p, mu):
    prev = jnp.pad(p, ((0, 0), (1, 0), (0, 0)))[:, :-1]
    return p + (prev - p) * mu


def _gla_mixer(q, k, v, g, a_lr, w_a2, b_a, ln_w, ln_b):
    dt = q.dtype
    B, S, _ = q.shape
    H, dk, C = GLA_HEADS, HEAD_DIM, GLA_CHUNK
    n = S // C
    f32 = jnp.float32
    log_a = jax.nn.log_sigmoid((a_lr @ w_a2 + b_a).astype(f32)) / GLA_TAU

    def chunks(t):
        return t.astype(f32).reshape(B, n, C, H, dk).transpose(1, 0, 3, 2, 4)

    qc, kc, vc, ac = chunks(q * dk ** -0.5), chunks(k), chunks(v), chunks(log_a)
    causal = jnp.tril(jnp.ones((C, C), bool))[:, :, None]

    def step(state, inp):
        qi, ki, vi, ai = inp
        b = jnp.cumsum(ai, axis=2)
        inter = jnp.einsum('bhtk,bhkv->bhtv', qi * jnp.exp(b), state)
        diff = b[:, :, :, None, :] - b[:, :, None, :, :]
        decay = jnp.exp(jnp.where(causal, diff, -jnp.inf))
        scores = jnp.einsum('bhtk,bhsk,bhtsk->bhts', qi, ki, decay)
        intra = jnp.einsum('bhts,bhsv->bhtv', scores, vi)
        b_end = b[:, :, -1:, :]
        state = (jnp.exp(b_end[:, :, 0, :, None]) * state
                 + jnp.einsum('bhsk,bhsv->bhkv', ki * jnp.exp(b_end - b), vi))
        return state, inter + intra

    s0 = jnp.zeros((B, H, dk, dk), f32)
    _, o = lax.scan(step, s0, (qc, kc, vc, ac))
    o = o.transpose(1, 0, 3, 2, 4).reshape(B, S, H * dk)
    o = _head_norm(o, ln_w, ln_b, H, LN_EPS)
    return (o * jax.nn.silu(g.astype(f32))).astype(dt)


def _rwkv7_mixer(r, k, v, w_lr, a_lr, g_lr, w0, w2, a0, a2, g2, k_k, k_a, r_k, ln_w, ln_b):
    dt = r.dtype
    B, S, _ = r.shape
    H, N = RWKV_HEADS, HEAD_DIM
    f32 = jnp.float32
    r, k, v = r.astype(f32), k.astype(f32), v.astype(f32)
    w_log = -jax.nn.softplus(-(w0 + jnp.tanh(w_lr) @ w2).astype(f32)) - 0.5
    decay = jnp.exp(-jnp.exp(w_log))
    a = jax.nn.sigmoid((a0 + a_lr @ a2).astype(f32))
    g = (jax.nn.sigmoid(g_lr) @ g2).astype(f32)
    kk = (k * k_k).reshape(B, S, H, N)
    kk = kk / jnp.maximum(jnp.sqrt(jnp.sum(kk * kk, axis=-1, keepdims=True)), 1e-12)
    k = k * (1.0 + (a - 1.0) * k_a)

    def heads(t):
        return t.reshape(B, S, H, N).transpose(1, 0, 2, 3)

    a_h = a.reshape(B, S, H, N)
    xs = (heads(r), heads(decay), heads(k), heads(v),
          (-kk).transpose(1, 0, 2, 3), (kk * a_h).transpose(1, 0, 2, 3))

    def step(state, inp):
        r_t, w_t, k_t, v_t, a_t, b_t = inp
        sa = jnp.einsum('bhvk,bhk->bhv', state, a_t)
        state = (state * w_t[:, :, None, :] + sa[..., None] * b_t[:, :, None, :]
                 + v_t[..., None] * k_t[:, :, None, :])
        return state, jnp.einsum('bhvk,bhk->bhv', state, r_t)

    s0 = jnp.zeros((B, H, N, N), f32)
    _, y = lax.scan(step, s0, xs)
    y = y.transpose(1, 0, 2, 3).reshape(B, S, H * N)
    y = _head_norm(y, ln_w, ln_b, H, RWKV_GN_EPS)
    bonus = (jnp.sum((r * k).reshape(B, S, H, N) * r_k, axis=-1, keepdims=True)
             * v.reshape(B, S, H, N)).reshape(B, S, H * N)
    return ((y + bonus) * g).astype(dt)


def _compress(t, pos_emb, w1, w2):
    B, S, G, hd = t.shape
    n_sub = NSA_CMP_BLOCK // NSA_CMP_STRIDE
    ncb = S // NSA_CMP_STRIDE
    nc = ncb - n_sub + 1
    t_s = t.reshape(B, ncb, NSA_CMP_STRIDE, G, hd)
    blocks = jnp.concatenate([t_s[:, j:j + nc] for j in range(n_sub)], axis=2)
    blocks = blocks + pos_emb[None, None, :, None, :]
    flat = blocks.transpose(0, 1, 3, 2, 4).reshape(B, nc, G, NSA_CMP_BLOCK * hd)
    return jax.nn.gelu(flat @ w1) @ w2


def _overlap_matrix(seq):
    nc = seq // NSA_CMP_STRIDE - NSA_CMP_BLOCK // NSA_CMP_STRIDE + 1
    ns = seq // NSA_SEL_BLOCK
    c0 = np.arange(nc) * NSA_CMP_STRIDE
    s0 = np.arange(ns) * NSA_SEL_BLOCK
    lo = np.maximum(c0[:, None], s0[None, :])
    hi = np.minimum(c0[:, None] + NSA_CMP_BLOCK, s0[None, :] + NSA_SEL_BLOCK)
    return (np.maximum(hi - lo, 0) / NSA_CMP_STRIDE).astype(np.float32)


def _selected_attention(q, k, v, idx, pos):
    B, S, G, HPG, hd = q.shape
    n = idx.shape[-1]
    ns = S // NSA_SEL_BLOCK
    kb = k.reshape(B, ns, NSA_SEL_BLOCK, G, hd).transpose(0, 3, 1, 2, 4)
    vb = v.reshape(B, ns, NSA_SEL_BLOCK, G, hd).transpose(0, 3, 1, 2, 4)
    qcs = NSA_SEL_QCHUNK
    nq = S // qcs
    q_ch = q.reshape(B, nq, qcs, G, HPG, hd).transpose(1, 0, 2, 3, 4, 5)
    idx_ch = idx.reshape(B, G, nq, qcs, n).transpose(2, 0, 1, 3, 4)
    pos_ch = pos.reshape(nq, qcs)
    bi = jnp.arange(B)[:, None, None, None]
    gi = jnp.arange(G)[None, :, None, None]
    offs = jnp.arange(NSA_SEL_BLOCK)

    def one(args):
        qc, ic, tc = args
        kg = kb[bi, gi, ic]
        vg = vb[bi, gi, ic]
        s = jnp.einsum('bqghd,bgqnkd->bghqnk', qc, kg).astype(jnp.float32)
        kpos = ic[..., None] * NSA_SEL_BLOCK + offs
        valid = kpos <= tc[None, None, :, None, None]
        s = jnp.where(valid[:, :, None], s, MASK_NEG).reshape(B, G, HPG, qcs, n * NSA_SEL_BLOCK)
        pr = jax.nn.softmax(s, axis=-1).reshape(B, G, HPG, qcs, n, NSA_SEL_BLOCK)
        return jnp.einsum('bghqnk,bgqnkd->bqghd', pr.astype(vg.dtype), vg)

    o = lax.map(one, (q_ch, idx_ch, pos_ch))
    return o.transpose(1, 0, 2, 3, 4, 5).reshape(B, S, G, HPG, hd)


def _window_attention(q, k, v):
    B, S, G, HPG, hd = q.shape
    qb_sz, win = NSA_WIN_QBLOCK, NSA_WINDOW
    nb = S // qb_sz
    kp = jnp.pad(k, ((0, 0), (win, 0), (0, 0), (0, 0)))
    vp = jnp.pad(v, ((0, 0), (win, 0), (0, 0), (0, 0)))
    q_bl = q.reshape(B, nb, qb_sz, G, HPG, hd).transpose(1, 0, 2, 3, 4, 5)
    rel = jnp.arange(qb_sz)[:, None] + win - jnp.arange(qb_sz + win)[None, :]

    def one(args):
        qb, i = args
        start = i * qb_sz
        kb = lax.dynamic_slice_in_dim(kp, start, qb_sz + win, axis=1)
        vb = lax.dynamic_slice_in_dim(vp, start, qb_sz + win, axis=1)
        s = jnp.einsum('bqghd,bkgd->bghqk', qb, kb).astype(jnp.float32)
        kpos = start - win + jnp.arange(qb_sz + win)
        valid = (rel >= 0) & (rel < win) & (kpos[None, :] >= 0)
        pr = jax.nn.softmax(jnp.where(valid, s, MASK_NEG), axis=-1)
        return jnp.einsum('bghqk,bkgd->bqghd', pr.astype(vb.dtype), vb)

    o = lax.map(one, (q_bl, jnp.arange(nb)))
    return o.transpose(1, 0, 2, 3, 4, 5).reshape(B, S, G, HPG, hd)


def _nsa_mixer(h, pos, pos_k, pos_v, wk1, wk2, wv1, wv2):
    dt = h.dtype
    B, S, _ = h.shape
    G, HPG, hd = NSA_KV_HEADS, NSA_HEADS // NSA_KV_HEADS, HEAD_DIM
    q, kc, vc, ks, vs, kw, vw, gate = _split(h, NSA_COLS)
    q = _rope(q.reshape(B, S, G, HPG, hd), pos) * hd ** -0.5
    kc, ks, kw = (_rope(t.reshape(B, S, G, hd), pos) for t in (kc, ks, kw))
    vc, vs, vw = (t.reshape(B, S, G, hd) for t in (vc, vs, vw))

    k_cmp = _compress(kc, pos_k, wk1, wk2)
    v_cmp = _compress(vc, pos_v, wv1, wv2)
    nc = k_cmp.shape[1]
    s_cmp = jnp.einsum('bsghd,bcgd->bghsc', q, k_cmp).astype(jnp.float32)
    block_end = jnp.arange(nc) * NSA_CMP_STRIDE + NSA_CMP_BLOCK - 1
    valid_c = block_end[None, :] <= pos[:, None]
    p_cmp = jax.nn.softmax(jnp.where(valid_c, s_cmp, MASK_NEG), axis=-1) * valid_c
    o_cmp = jnp.einsum('bghsc,bcgd->bsghd', p_cmp.astype(v_cmp.dtype), v_cmp)

    ns = S // NSA_SEL_BLOCK
    overlap = jnp.asarray(_overlap_matrix(S))
    imp = jnp.einsum('bghsc,cj->bgsj', p_cmp, overlap)
    cur = pos // NSA_SEL_BLOCK
    j = jnp.arange(ns)[None, :]
    forced = (j == 0) | (j == cur[:, None]) | (j == cur[:, None] - 1)
    sel_score = jnp.where(forced, 1e9, jnp.where(j > cur[:, None], -1e9, imp))
    _, idx = lax.top_k(sel_score, min(NSA_N_SELECT, ns))
    o_slc = _selected_attention(q, ks, vs, idx, pos)

    o_win = _window_attention(q, kw, vw)

    gt = jax.nn.sigmoid(gate.astype(jnp.float32)).reshape(B, S, G, HPG, 3)
    o = gt[..., 0:1] * o_cmp + gt[..., 1:2] * o_slc + gt[..., 2:3] * o_win
    return o.reshape(B, S, NSA_WIDTH).astype(dt)


def setup_inputs(seed: int = 0) -> dict:
    key = jax.random.key(seed)
    ks = jax.random.split(key, 40)
    D, L = D_MODEL, DEPTH

    def nrm(k, shape, scale):
        return jax.random.normal(k, shape, jnp.float32) * scale

    def gain(k, shape):
        return 1.0 + 0.05 * jax.random.normal(k, shape, jnp.float32)

    rw_in = sum(RWKV_COLS)
    return {
        'x': nrm(ks[0], (BATCH, SEQ, D), 1.0),
        'w_in': nrm(ks[1], (L, D, IN_COLS), D ** -0.5),
        'w_in_vres': nrm(ks[2], (L - 1, D, RWKV_VRES_RANK), D ** -0.5),
        'gla_w_a2': nrm(ks[3], (L, GLA_GATE_RANK, GLA_WIDTH), GLA_GATE_RANK ** -0.5),
        'gla_b_a': nrm(ks[4], (L, GLA_WIDTH), 0.1),
        'gla_ln_w': gain(ks[5], (L, GLA_WIDTH)),
        'gla_ln_b': nrm(ks[6], (L, GLA_WIDTH), 0.02),
        'rwkv_mu': jax.random.uniform(ks[7], (L, rw_in), jnp.float32),
        'rwkv_mu_vres': jax.random.uniform(ks[8], (L - 1, RWKV_VRES_RANK), jnp.float32),
        'rwkv_w0': jax.random.uniform(ks[9], (L, RWKV_WIDTH), jnp.float32, -5.0, 1.0),
        'rwkv_w2': nrm(ks[10], (L, RWKV_DECAY_RANK, RWKV_WIDTH), 0.5 * RWKV_DECAY_RANK ** -0.5),
        'rwkv_a0': nrm(ks[11], (L, RWKV_WIDTH), 0.1),
        'rwkv_a2': nrm(ks[12], (L, RWKV_ICLR_RANK, RWKV_WIDTH), RWKV_ICLR_RANK ** -0.5),
        'rwkv_v0': nrm(ks[13], (L - 1, RWKV_WIDTH), 0.1),
        'rwkv_v2': nrm(ks[14], (L - 1, RWKV_VRES_RANK, RWKV_WIDTH), RWKV_VRES_RANK ** -0.5),
        'rwkv_g2': nrm(ks[15], (L, RWKV_GATE_RANK, RWKV_WIDTH), RWKV_GATE_RANK ** -0.5),
        'rwkv_k_k': 0.85 + 0.05 * jax.random.normal(ks[16], (L, RWKV_WIDTH), jnp.float32),
        'rwkv_k_a': gain(ks[17], (L, RWKV_WIDTH)),
        'rwkv_r_k': nrm(ks[18], (L, RWKV_HEADS, HEAD_DIM), 0.1),
        'rwkv_ln_w': gain(ks[19], (L, RWKV_WIDTH)),
        'rwkv_ln_b': nrm(ks[20], (L, RWKV_WIDTH), 0.02),
        'nsa_pos_k': nrm(ks[21], (L, NSA_CMP_BLOCK, HEAD_DIM), 0.02),
        'nsa_pos_v': nrm(ks[22], (L, NSA_CMP_BLOCK, HEAD_DIM), 0.02),
        'nsa_wk1': nrm(ks[23], (L, NSA_CMP_BLOCK * HEAD_DIM, NSA_CMP_HIDDEN), (NSA_CMP_BLOCK * HEAD_DIM) ** -0.5),
        'nsa_wk2': nrm(ks[24], (L, NSA_CMP_HIDDEN, HEAD_DIM), NSA_CMP_HIDDEN ** -0.5),
        'nsa_wv1': nrm(ks[25], (L, NSA_CMP_BLOCK * HEAD_DIM, NSA_CMP_HIDDEN), (NSA_CMP_BLOCK * HEAD_DIM) ** -0.5),
        'nsa_wv2': nrm(ks[26], (L, NSA_CMP_HIDDEN, HEAD_DIM), NSA_CMP_HIDDEN ** -0.5),
        'w_out': nrm(ks[27], (L, D, D), DEEPNORM_BETA * D ** -0.5),
        'ln1_w': gain(ks[28], (L, D)),
        'ln1_b': nrm(ks[29], (L, D), 0.02),
        'ffn_w_gate': nrm(ks[30], (L, D, FFN_HIDDEN), D ** -0.5),
        'ffn_w_up': nrm(ks[31], (L, D, FFN_HIDDEN), D ** -0.5),
        'ffn_w_down': nrm(ks[32], (L, FFN_HIDDEN, D), DEEPNORM_BETA * FFN_HIDDEN ** -0.5),
        'ln2_w': gain(ks[33], (L, D)),
        'ln2_b': nrm(ks[34], (L, D), 0.02),
    }


def reference(x, w_in, w_in_vres, gla_w_a2, gla_b_a, gla_ln_w, gla_ln_b,
              rwkv_mu, rwkv_mu_vres, rwkv_w0, rwkv_w2, rwkv_a0, rwkv_a2, rwkv_v0, rwkv_v2,
              rwkv_g2, rwkv_k_k, rwkv_k_a, rwkv_r_k, rwkv_ln_w, rwkv_ln_b,
              nsa_pos_k, nsa_pos_v, nsa_wk1, nsa_wk2, nsa_wv1, nsa_wv2,
              w_out, ln1_w, ln1_b, ffn_w_gate, ffn_w_up, ffn_w_down, ln2_w, ln2_b):
    pos = jnp.arange(x.shape[1], dtype=jnp.int32)
    v_first = None
    for l in range(DEPTH):
        w_cols = w_in[l] if l == 0 else jnp.concatenate([w_in[l], w_in_vres[l - 1]], axis=1)
        h = x @ w_cols
        h_gla, h_rwkv, h_nsa, h_vres = _split(
            h, (sum(GLA_COLS), sum(RWKV_COLS), sum(NSA_COLS), h.shape[-1] - IN_COLS))

        gq, gk, gv, gg, galr = _split(h_gla, GLA_COLS)
        o_gla = _gla_mixer(gq, gk, gv, gg, galr, gla_w_a2[l], gla_b_a[l], gla_ln_w[l], gla_ln_b[l])

        rr, rk, rv, rwlr, ralr, rglr = _split(_token_shift_mix(h_rwkv, rwkv_mu[l]), RWKV_COLS)
        if l == 0:
            v_first = rv
        else:
            vlr = _token_shift_mix(h_vres, rwkv_mu_vres[l - 1])
            rv = rv + (v_first - rv) * jax.nn.sigmoid(rwkv_v0[l - 1] + vlr @ rwkv_v2[l - 1])
        o_rwkv = _rwkv7_mixer(rr, rk, rv, rwlr, ralr, rglr, rwkv_w0[l], rwkv_w2[l], rwkv_a0[l],
                              rwkv_a2[l], rwkv_g2[l], rwkv_k_k[l], rwkv_k_a[l], rwkv_r_k[l],
                              rwkv_ln_w[l], rwkv_ln_b[l])

        o_nsa = _nsa_mixer(h_nsa, pos, nsa_pos_k[l], nsa_pos_v[l], nsa_wk1[l], nsa_wk2[l],
                           nsa_wv1[l], nsa_wv2[l])

        mix = jnp.concatenate([o_gla, o_rwkv, o_nsa], axis=-1) @ w_out[l]
        x = _layer_norm(DEEPNORM_ALPHA * x + mix, ln1_w[l], ln1_b[l])

        ffn = (jax.nn.silu(x @ ffn_w_gate[l]) * (x @ ffn_w_up[l])) @ ffn_w_down[l]
        x = _layer_norm(DEEPNORM_ALPHA * x + ffn, ln2_w[l], ln2_b[l])
    return x
```

```cpp
#include <hip/hip_runtime.h>
#include <hip/hip_cooperative_groups.h>
#include <cstdio>
#include <cstdint>
namespace cg = cooperative_groups;
__device__ __forceinline__ int tid_() { int t = threadIdx.x; asm volatile("" : "+v"(t)); return t; }
namespace pg8 {
#define PG8_LAS __attribute__((address_space(3)))
typedef unsigned short bf16_t;
typedef short bf16x8 __attribute__((ext_vector_type(8)));
typedef float f32x4 __attribute__((ext_vector_type(4)));
typedef unsigned u32x4 __attribute__((ext_vector_type(4)));
constexpr int BM = 256, BK = 64, HALF = 128, HTB = HALF * BK * 2  , STAGE_BYTES = 8 * HTB, NXCD = 8, WGM = 8;

__host__ __device__ __forceinline__ int lds_byte(int r, int c) { const int st = (r >> 4) * 2 + (c >> 5), rr = r & 15, cc = c & 31, ob = rr * 64 + cc * 2; return st * 1024 + (ob ^ (((ob >> 9) & 1) << 5)); }
__host__ __device__ __forceinline__ void stage_rc(int b, int& R, int& C) { const int st = b / 1024, sb = b % 1024, swz = sb ^ (((sb >> 9) & 1) << 5); R = (st >> 1) * 16 + swz / 64; C = (st & 1) * 32 + (swz % 64) / 2; }
__host__ __device__ __forceinline__ int perm32(int rho) { const int n = rho >> 4, i = rho & 15; return 8 * (i >> 2) + 4 * n + (i & 3); }

struct Unit { int pm, pn; };
struct Gemm { const bf16_t* A; const bf16_t* Bt; int M, N, K; };

struct StaticOrder {
    int nM, nN, nwg, G, c, wgm;
    __host__ __device__ void init(int M, int N, int G_, int c_, int wgm_ = WGM) { nM = M / BM; nN = N / BM; nwg = nM * nN; G = G_; c = c_; wgm = wgm_; }
    __host__ __device__ bool next(int i, Unit& u) const {
        const long L = (long)i * G + c; if (L >= nwg) return false;
        int wgid = (int)L; { const int q = nwg / NXCD, r = nwg % NXCD, xcd = wgid % NXCD, off = wgid / NXCD; wgid = (xcd < r ? xcd * (q + 1) : r * (q + 1) + (xcd - r) * q) + off; }
        const int nig = wgm * nN, gid = wgid / nig, fm = gid * wgm, gsz = (nM - fm) < wgm ? (nM - fm) : wgm;
        u.pm = fm + ((wgid % nig) % gsz); u.pn = (wgid % nig) / gsz; return true;
    }
    __device__ __forceinline__ void a_ready(const Unit&) const {}
    __device__ __forceinline__ void done(const Unit&) const {}
};

__device__ __forceinline__ unsigned cvt_pk_bf16(float lo, float hi) { unsigned r; asm volatile("v_cvt_pk_bf16_f32 %0, %1, %2" : "=v"(r) : "v"(lo), "v"(hi)); return r; }
template <class Epi, class Sched, bool ALIGN_EPI = false, bool SP2 = false>
__device__ __forceinline__ void gemm_phase(PG8_LAS unsigned char* lds, const Gemm g, const Sched& S, const Epi& E) {
    const int tid = tid_(), wid = __builtin_amdgcn_readfirstlane(tid >> 6), lane = tid & 63, wr = wid >> 2, wc = wid & 3, fr = lane & 15, fq = lane >> 4;
    const int K = g.K, nt = K / BK;
    unsigned voffA[2], voffB[2];
#pragma unroll
    for (int i = 0; i < 2; ++i) { int R, C; stage_rc(tid * 16 + i * 8192, R, C); const int Rb = Epi::PERM ? ((R & ~31) + perm32(R & 31)) : R;
        voffA[i] = (unsigned)(R * K + C) * 2u; voffB[i] = (unsigned)(Rb * K + C) * 2u; }
    const size_t kstep = (size_t)(BK * 2);
    const size_t hstep = (size_t)HALF * K * 2;
    const size_t tstep = 2 * hstep;
    const unsigned ldsw = (unsigned)wid * 1024u;
    const int aoff = lds_byte(wr * 64 + fr, fq * 8), boff = lds_byte(wc * 32 + fr, fq * 8);
#define PG8_SA(b, h) (((b) * 2 + (h)) * HTB)
#define PG8_SB(b, h) ((4 + (b) * 2 + (h)) * HTB)
#define PG8_STAGE(bufoff, gbase, voff) do { _Pragma("unroll") for (int _i = 0; _i < 2; ++_i) \
        __builtin_amdgcn_global_load_lds((const unsigned*)((const char*)(gbase) + (voff)[_i]), (PG8_LAS unsigned*)(lds + (bufoff) + ldsw + _i * 8192), 16, 0, 0); } while (0)
#define PG8_LDA(dst, b, h) do { _Pragma("unroll") for (int m = 0; m < 4; ++m) _Pragma("unroll") for (int k = 0; k < 2; ++k) dst[m][k] = *(const PG8_LAS bf16x8*)(lds + PG8_SA(b, h) + aoff + m * 2048 + k * 1024); } while (0)
#define PG8_LDB(dst, b, h) do { _Pragma("unroll") for (int n = 0; n < 2; ++n) _Pragma("unroll") for (int k = 0; k < 2; ++k) dst[n][k] = *(const PG8_LAS bf16x8*)(lds + PG8_SB(b, h) + boff + n * 2048 + k * 1024); } while (0)
#define PG8_MMA(ai, bj, At, Bt) do { __builtin_amdgcn_s_setprio(1); _Pragma("unroll") for (int m = 0; m < 4; ++m) _Pragma("unroll") for (int n = 0; n < 2; ++n) _Pragma("unroll") for (int k = 0; k < 2; ++k) \
        acc[ai][bj][m][n] = __builtin_amdgcn_mfma_f32_16x16x32_bf16(Bt[n][k], At[m][k], acc[ai][bj][m][n], 0, 0, 0); __builtin_amdgcn_s_setprio(0); } while (0)
#define PG8_WAIT_V(n) asm volatile("s_waitcnt vmcnt(" #n ")" ::: "memory")
#define PG8_WAIT_L(n) asm volatile("s_waitcnt lgkmcnt(" #n ")" ::: "memory")
#define PG8_BAR __builtin_amdgcn_s_barrier()
#define PG8_SCHED __builtin_amdgcn_sched_barrier(0)
    Unit cur, nxt; int ui = 0;
    if (!S.next(0, cur)) return;
    f32x4 acc[2][2][4][2];
#pragma unroll
    for (int a = 0; a < 2; ++a)
#pragma unroll
        for (int b = 0; b < 2; ++b)
#pragma unroll
            for (int m = 0; m < 4; ++m)
#pragma unroll
                for (int n = 0; n < 2; ++n) acc[a][b][m][n] = (f32x4){0.f, 0.f, 0.f, 0.f};
    bf16x8 At[4][2], B0[2][2], B1[2][2];
    const char* cA = (const char*)g.A + (size_t)cur.pm * tstep; const char* cB = (const char*)g.Bt + (size_t)cur.pn * tstep;
    S.a_ready(cur);
    if constexpr (SP2) {
        PG8_STAGE(PG8_SB(0, 0), cB, voffB); PG8_STAGE(PG8_SB(0, 1), cB + hstep, voffB); PG8_STAGE(PG8_SA(0, 0), cA, voffA); PG8_STAGE(PG8_SA(0, 1), cA + hstep, voffA);
        if (wr == 1) PG8_BAR;
        PG8_WAIT_V(2); PG8_BAR;
        PG8_STAGE(PG8_SB(1, 0), cB + kstep, voffB); PG8_STAGE(PG8_SA(1, 0), cA + kstep, voffA); PG8_STAGE(PG8_SB(1, 1), cB + hstep + kstep, voffB);
        PG8_WAIT_V(6); PG8_BAR;
    } else {
        PG8_STAGE(PG8_SB(0, 0), cB, voffB); PG8_STAGE(PG8_SA(0, 0), cA, voffA); PG8_STAGE(PG8_SB(0, 1), cB + hstep, voffB); PG8_STAGE(PG8_SA(0, 1), cA + hstep, voffA);
        if (wr == 1) PG8_BAR;
        PG8_WAIT_V(4); PG8_BAR;
        PG8_STAGE(PG8_SB(1, 0), cB + kstep, voffB); PG8_STAGE(PG8_SA(1, 0), cA + kstep, voffA); PG8_STAGE(PG8_SB(1, 1), cB + hstep + kstep, voffB);
        PG8_WAIT_V(6); PG8_BAR;
    }
    for (;;) {
        const bool has_next = S.next(ui + 1, nxt);
        const char* nA = has_next ? (const char*)g.A + (size_t)nxt.pm * tstep : cA; const char* nB = has_next ? (const char*)g.Bt + (size_t)nxt.pn * tstep : cB;
        for (int t = 0; t < nt; t += 2) {
            const bool last = (t == nt - 2);
            const char* a1 = cA + (size_t)(t + 1) * kstep;
            const char* a2 = last ? nA : cA + (size_t)(t + 2) * kstep; const char* b2 = last ? nB : cB + (size_t)(t + 2) * kstep;
            const char* a3 = a2 + kstep; const char* b3 = b2 + kstep;
            if (last && has_next) S.a_ready(nxt);
            if constexpr (SP2) {
            PG8_LDB(B0, 0, 0); PG8_LDB(B1, 0, 1); PG8_SCHED; PG8_LDA(At, 0, 0); PG8_STAGE(PG8_SA(1, 1), a1 + hstep, voffA);
            PG8_WAIT_V(8); PG8_WAIT_L(0); PG8_BAR; PG8_MMA(0, 0, At, B0); PG8_MMA(0, 1, At, B1); PG8_BAR; PG8_SCHED;
            PG8_LDA(At, 0, 1); PG8_STAGE(PG8_SB(0, 0), b2, voffB); PG8_STAGE(PG8_SB(0, 1), b2 + hstep, voffB); PG8_STAGE(PG8_SA(0, 0), a2, voffA);
            PG8_WAIT_V(8); PG8_WAIT_L(0); PG8_BAR; PG8_MMA(1, 0, At, B0); PG8_MMA(1, 1, At, B1); PG8_BAR; PG8_SCHED;
            PG8_LDB(B0, 1, 0); PG8_LDB(B1, 1, 1); PG8_SCHED; PG8_LDA(At, 1, 0); PG8_STAGE(PG8_SA(0, 1), a2 + hstep, voffA);
            PG8_WAIT_V(8); PG8_WAIT_L(0); PG8_BAR; PG8_MMA(0, 0, At, B0); PG8_MMA(0, 1, At, B1); PG8_BAR; PG8_SCHED;
            PG8_LDA(At, 1, 1); PG8_STAGE(PG8_SB(1, 0), b3, voffB); PG8_STAGE(PG8_SB(1, 1), b3 + hstep, voffB); PG8_STAGE(PG8_SA(1, 0), a3, voffA);
            PG8_WAIT_V(8); PG8_WAIT_L(0); PG8_BAR; PG8_MMA(1, 0, At, B0); PG8_MMA(1, 1, At, B1); PG8_BAR; PG8_SCHED;
            } else {
            PG8_LDB(B0, 0, 0); PG8_SCHED; PG8_LDA(At, 0, 0); PG8_STAGE(PG8_SA(1, 1), a1 + hstep, voffA);
            PG8_WAIT_L(8); PG8_BAR; PG8_WAIT_L(0); PG8_MMA(0, 0, At, B0); PG8_BAR; PG8_SCHED;
            PG8_LDB(B1, 0, 1); PG8_STAGE(PG8_SB(0, 0), b2, voffB);
            PG8_BAR; PG8_WAIT_L(0); PG8_MMA(0, 1, At, B1); PG8_BAR;
            PG8_LDA(At, 0, 1); PG8_STAGE(PG8_SA(0, 0), a2, voffA);
            PG8_BAR; PG8_WAIT_L(0); PG8_MMA(1, 0, At, B0); PG8_BAR; PG8_SCHED;
            PG8_STAGE(PG8_SB(0, 1), b2 + hstep, voffB);
            PG8_WAIT_V(6); PG8_BAR; PG8_MMA(1, 1, At, B1); PG8_BAR;
            PG8_LDB(B0, 1, 0); PG8_SCHED; PG8_LDA(At, 1, 0); PG8_STAGE(PG8_SA(0, 1), a2 + hstep, voffA);
            PG8_WAIT_L(8); PG8_BAR; PG8_WAIT_L(0); PG8_MMA(0, 0, At, B0); PG8_BAR; PG8_SCHED;
            PG8_LDB(B1, 1, 1); PG8_STAGE(PG8_SB(1, 0), b3, voffB);
            PG8_BAR; PG8_WAIT_L(0); PG8_MMA(0, 1, At, B1); PG8_BAR;
            PG8_LDA(At, 1, 1); PG8_STAGE(PG8_SA(1, 0), a3, voffA);
            PG8_BAR; PG8_WAIT_L(0); PG8_MMA(1, 0, At, B0); PG8_BAR; PG8_SCHED;
            PG8_STAGE(PG8_SB(1, 1), b3 + hstep, voffB);
            PG8_WAIT_V(6); PG8_BAR; PG8_MMA(1, 1, At, B1); PG8_BAR;
            }
        }
        if constexpr (ALIGN_EPI) { if (wr == 0) PG8_BAR; }
        if constexpr (!Epi::AFTER_DRAIN) { E(acc, cur, wr, wc, fr, fq); S.done(cur); }
        if (!has_next) break;
#pragma unroll
        for (int a = 0; a < 2; ++a)
#pragma unroll
            for (int b = 0; b < 2; ++b)
#pragma unroll
                for (int m = 0; m < 4; ++m)
#pragma unroll
                    for (int n = 0; n < 2; ++n) acc[a][b][m][n] = (f32x4){0.f, 0.f, 0.f, 0.f};
        cur = nxt; cA = nA; cB = nB; ++ui;
        if constexpr (ALIGN_EPI) { if (wr == 1) PG8_BAR; }
    }
    PG8_WAIT_V(0);
    if constexpr (!ALIGN_EPI) { if (wr == 0) PG8_BAR; }
    PG8_BAR;
    if constexpr (Epi::AFTER_DRAIN) { E.fused(acc, cur, wr, wc, fr, fq, lds, wid, lane); S.done(cur); }
#undef PG8_SA
#undef PG8_SB
#undef PG8_STAGE
#undef PG8_LDA
#undef PG8_LDB
#undef PG8_MMA
#undef PG8_WAIT_V
#undef PG8_WAIT_L
#undef PG8_BAR
#undef PG8_SCHED
}
}
#define LAS __attribute__((address_space(3)))
typedef unsigned short bf16;
typedef unsigned v4u __attribute__((ext_vector_type(4)));
typedef unsigned v2u __attribute__((ext_vector_type(2)));
typedef float f32x4 __attribute__((ext_vector_type(4)));
typedef float f32x2 __attribute__((ext_vector_type(2)));
typedef float f32x16 __attribute__((ext_vector_type(16)));
typedef short bf16x8 __attribute__((ext_vector_type(8)));
typedef short s16x4 __attribute__((ext_vector_type(4)));
#define LDS_WAIT() asm volatile("s_waitcnt lgkmcnt(0)" ::: "memory")
#define DI __device__ __forceinline__

constexpr int NBATCH = 16, SEQ = 2048, T = NBATCH * SEQ, D = 1024, HP = 3584, FF = 2816, FF2 = 5632, NWAVES = 8, NTHR = 512;
constexpr float ALPHA = 1.4142135623730951f;
constexpr float LN_EPS = 1e-5f;
constexpr int C_GQ = 0, C_GK = 256, C_GV = 512, C_GG = 768, C_GA = 1024;
constexpr int C_RW = 1040;
constexpr int C_RR = 1040, C_RK = 1296, C_RV = 1552, C_RWL = 1808, C_RAL = 1872, C_RGL = 1936;
constexpr int C_NQ = 2096, C_NKC = 2608, C_NVC = 2736, C_NKS = 2864, C_NVS = 2992, C_NKW = 3120, C_NVW = 3248, C_NG = 3376, C_VR = 3400;
constexpr size_t MiB = 1u << 20;
constexpr size_t WS_CTL = 0, CTL_BYTES = 65536;
constexpr size_t WS_COS = 1 * MiB, WS_SIN = WS_COS + 256 * 1024;
constexpr size_t WS_KCMP = WS_COS + 512 * 1024, WS_VCMP = WS_KCMP + 512 * 1024;
constexpr size_t WS_SMALL = 3 * MiB, SMALL_STRIDE = 512 * 1024;
constexpr size_t SM_W2T = 0, SM_A2T = 32768, SM_G2T = 65536, SM_V2T = 65536 + 98304, SM_WK2T = SM_V2T + 32768, SM_WV2T = SM_WK2T + 32768;
constexpr size_t WS_WIN = 4 * MiB, WIN_STRIDE = 7 * MiB;
constexpr size_t WS_WOUT = 18 * MiB, WOUT_STRIDE = 2 * MiB;
constexpr size_t WS_WGU = 22 * MiB, WGU_STRIDE = 11 * MiB;
constexpr size_t WS_WD = 44 * MiB, WD_STRIDE = 11 * MiB / 2;
constexpr size_t WS_WC1 = 55 * MiB;
constexpr size_t WS_ACT = 64 * MiB, WS_H = 128 * MiB;
constexpr size_t WS_RW = 352 * MiB, WS_RR = 384 * MiB, WS_RK = 400 * MiB, WS_RV = 416 * MiB, WS_RA = 432 * MiB, WS_RB = 448 * MiB, WS_VF = 464 * MiB, WS_END = 480 * MiB;
#ifndef WGM_IN
#define WGM_IN 8
#endif
#ifndef WGM_F1
#define WGM_F1 8
#endif
#ifndef WGM_N1K
#define WGM_N1K 8
#endif
constexpr int LDS_BYTES = 153600;
constexpr int XB_LDS_OFF = 152000, CW_BAR = 4096;

struct Args { const float* in[35]; float* out; unsigned char* ws; };
typedef const __attribute__((address_space(4))) Args* KA;
#define ARGS() ({ KA _p = (KA)__builtin_amdgcn_kernarg_segment_ptr(); asm volatile("" : "+s"(_p)); _p; })
enum { I_X = 0, I_WIN, I_WINV, I_GLA_A2, I_GLA_BA, I_GLA_LNW, I_GLA_LNB, I_MU, I_MUV, I_W0, I_W2, I_A0, I_A2, I_V0, I_V2, I_G2, I_KK, I_KA, I_RK, I_RLNW, I_RLNB,
       I_POSK, I_POSV, I_WK1, I_WK2, I_WV1, I_WV2, I_WOUT, I_LN1W, I_LN1B, I_FG, I_FU, I_FD, I_LN2W, I_LN2B };

DI int bid_() { int t = blockIdx.x; asm volatile("" : "+s"(t)); return t; }
DI unsigned f2bf(float f) { unsigned u = __builtin_bit_cast(unsigned, f); return (u + 0x7fffu + ((u >> 16) & 1u)) >> 16; }
typedef __bf16 bf16x2_t __attribute__((ext_vector_type(2)));
DI unsigned pk2(float lo, float hi) { const f32x2 v = {lo, hi}; const bf16x2_t b = __builtin_convertvector(v, bf16x2_t); return __builtin_bit_cast(unsigned, b); }
DI float bf2f(unsigned short b) { return __builtin_bit_cast(float, (unsigned)b << 16); }
DI float bflo(unsigned u) { return __builtin_bit_cast(float, u << 16); }
DI float bfhi(unsigned u) { return __builtin_bit_cast(float, u & 0xffff0000u); }
DI float wave_sum(float v) {
#pragma unroll
    for (int o = 1; o < 64; o <<= 1) v += __shfl_xor(v, o);
    return v;
}
DI float fast_tanh(float x) { return 1.f - 2.f * __builtin_amdgcn_rcpf(1.f + __expf(2.f * x)); }
DI float sigmoidf_(float x) { return __builtin_amdgcn_rcpf(1.f + __expf(-x)); }

struct EpiH {
    static constexpr bool PERM = true, AFTER_DRAIN = false;
    bf16* O; int ldc;
    DI void operator()(const pg8::f32x4 (&acc)[2][2][4][2], const pg8::Unit& u, int wr, int wc, int fr, int fq) const {
        const int row0 = u.pm * 256 + wr * 64 + fr, col0 = u.pn * 256 + wc * 32 + 8 * fq;
#pragma unroll
        for (int ai = 0; ai < 2; ++ai)
#pragma unroll
            for (int m = 0; m < 4; ++m) { bf16* rowp = O + (size_t)(row0 + ai * 128 + m * 16) * ldc + col0;
#pragma unroll
                for (int bj = 0; bj < 2; ++bj) { const pg8::f32x4 v0 = acc[ai][bj][m][0], v1 = acc[ai][bj][m][1];
                    v4u w; w.x = pg8::cvt_pk_bf16(v0[0], v0[1]); w.y = pg8::cvt_pk_bf16(v0[2], v0[3]); w.z = pg8::cvt_pk_bf16(v1[0], v1[1]); w.w = pg8::cvt_pk_bf16(v1[2], v1[3]);
                    *(v4u*)(rowp + bj * 128) = w; } }
    }
};
struct EpiRes {
    static constexpr bool PERM = true, AFTER_DRAIN = false;
    const float* res; float* out;
    DI void operator()(const pg8::f32x4 (&acc)[2][2][4][2], const pg8::Unit& u, int wr, int wc, int fr, int fq) const {
        const int row0 = u.pm * 256 + wr * 64 + fr, col0 = u.pn * 256 + wc * 32 + 8 * fq;
#pragma unroll
        for (int ai = 0; ai < 2; ++ai) {
            f32x4 rv[4][2][2];
#pragma unroll
            for (int m = 0; m < 4; ++m) { const size_t off = (size_t)(row0 + ai * 128 + m * 16) * D + col0;
#pragma unroll
                for (int bj = 0; bj < 2; ++bj)
#pragma unroll
                    for (int n = 0; n < 2; ++n) rv[m][bj][n] = *(const f32x4*)(res + off + bj * 128 + 4 * n); }
#pragma unroll
            for (int m = 0; m < 4; ++m) { const size_t off = (size_t)(row0 + ai * 128 + m * 16) * D + col0;
#pragma unroll
                for (int bj = 0; bj < 2; ++bj)
#pragma unroll
                    for (int n = 0; n < 2; ++n) { const f32x4 r = rv[m][bj][n]; const pg8::f32x4 a = acc[ai][bj][m][n];
                        f32x4 o; o[0] = ALPHA * r[0] + a[0]; o[1] = ALPHA * r[1] + a[1]; o[2] = ALPHA * r[2] + a[2]; o[3] = ALPHA * r[3] + a[3];
                        *(f32x4*)(out + off + bj * 128 + 4 * n) = o; } }
        }
    }
};
struct EpiResB {
    static constexpr bool PERM = true, AFTER_DRAIN = false;
    const bf16* res; float* out;
    DI void operator()(const pg8::f32x4 (&acc)[2][2][4][2], const pg8::Unit& u, int wr, int wc, int fr, int fq) const {
        const int row0 = u.pm * 256 + wr * 64 + fr, col0 = u.pn * 256 + wc * 32 + 8 * fq;
        v4u rb[2][4][2];
#pragma unroll
        for (int ai = 0; ai < 2; ++ai)
#pragma unroll
            for (int m = 0; m < 4; ++m) { const size_t off = (size_t)(row0 + ai * 128 + m * 16) * D + col0;
#pragma unroll
                for (int bj = 0; bj < 2; ++bj) rb[ai][m][bj] = *(const v4u*)(res + off + bj * 128); }
#pragma unroll
        for (int ai = 0; ai < 2; ++ai)
#pragma unroll
            for (int m = 0; m < 4; ++m) { const size_t off = (size_t)(row0 + ai * 128 + m * 16) * D + col0;
#pragma unroll
                for (int bj = 0; bj < 2; ++bj) { const v4u q = rb[ai][m][bj]; const float r8[8] = {bflo(q.x), bfhi(q.x), bflo(q.y), bfhi(q.y), bflo(q.z), bfhi(q.z), bflo(q.w), bfhi(q.w)};
#pragma unroll
                    for (int n = 0; n < 2; ++n) { const pg8::f32x4 a = acc[ai][bj][m][n];
                        f32x4 o; o[0] = ALPHA * r8[4 * n] + a[0]; o[1] = ALPHA * r8[4 * n + 1] + a[1]; o[2] = ALPHA * r8[4 * n + 2] + a[2]; o[3] = ALPHA * r8[4 * n + 3] + a[3];
                        *(f32x4*)(out + off + bj * 128 + 4 * n) = o; } } }
    }
};
struct EpiSwiGLU {
    static constexpr bool PERM = true, AFTER_DRAIN = false;
    bf16* O;
    DI void operator()(const pg8::f32x4 (&acc)[2][2][4][2], const pg8::Unit& u, int wr, int wc, int fr, int fq) const {
        const int row0 = u.pm * 256 + wr * 64 + fr, col0 = u.pn * 128 + wc * 32 + 8 * fq;
#pragma unroll
        for (int ai = 0; ai < 2; ++ai)
#pragma unroll
            for (int m = 0; m < 4; ++m) { bf16* rowp = O + (size_t)(row0 + ai * 128 + m * 16) * FF + col0;
                float hv[8];
#pragma unroll
                for (int n = 0; n < 2; ++n)
#pragma unroll
                    for (int j = 0; j < 4; ++j) { const float g = acc[ai][0][m][n][j], up = acc[ai][1][m][n][j]; hv[4 * n + j] = g * __builtin_amdgcn_rcpf(1.f + __expf(-g)) * up; }
                v4u w; w.x = pg8::cvt_pk_bf16(hv[0], hv[1]); w.y = pg8::cvt_pk_bf16(hv[2], hv[3]); w.z = pg8::cvt_pk_bf16(hv[4], hv[5]); w.w = pg8::cvt_pk_bf16(hv[6], hv[7]);
                *(v4u*)rowp = w; }
    }
};

DI void tr_item(const float* W, int K, int N, bf16* WT, int ldt, int row_off, int mode, int kb, int nb, LAS float* scr, int lane) {
    const int k0 = 64 * kb, n0 = 32 * nb;
#pragma unroll
    for (int i = 0; i < 32; ++i) { const int kk = 2 * i + (lane >> 5), k = k0 + kk, n = n0 + (lane & 31); scr[kk * 33 + (lane & 31)] = (k < K && n < N) ? W[(size_t)k * N + n] : 0.f; }
    LDS_WAIT();
    const int c = lane & 7;
#pragma unroll
    for (int j = 0; j < 4; ++j) { const int nn = (lane >> 3) + 8 * j, n = n0 + nn; const LAS float* s = scr + (8 * c) * 33 + nn;
        v4u o; o.x = pk2(s[0 * 33], s[1 * 33]); o.y = pk2(s[2 * 33], s[3 * 33]); o.z = pk2(s[4 * 33], s[5 * 33]); o.w = pk2(s[6 * 33], s[7 * 33]);
        int dr = row_off + n; if (mode) dr = ((n >> 7) << 8) + (n & 127) + (mode == 2 ? 128 : 0);
        if (n < N && k0 + 8 * c + 8 <= ldt) *(v4u*)(WT + (size_t)dr * ldt + k0 + 8 * c) = o; }
    LDS_WAIT();
}
DI void tr_load(float (&v)[32], const float* W, int K, int N, int kb, int nb, int lane) {
    const int k0 = 64 * kb, n0 = 32 * nb;
#pragma unroll
    for (int i = 0; i < 32; ++i) { const int kk = 2 * i + (lane >> 5), k = k0 + kk, n = n0 + (lane & 31); v[i] = (k < K && n < N) ? W[(size_t)k * N + n] : 0.f; }
}
DI void tr_finish(const float (&v)[32], int N, bf16* WT, int ldt, int row_off, int mode, int kb, int nb, LAS float* scr, int lane) {
    const int k0 = 64 * kb, n0 = 32 * nb;
#pragma unroll
    for (int i = 0; i < 32; ++i) scr[(2 * i + (lane >> 5)) * 33 + (lane & 31)] = v[i];
    LDS_WAIT();
    const int c = lane & 7;
#pragma unroll
    for (int j = 0; j < 4; ++j) { const int nn = (lane >> 3) + 8 * j, n = n0 + nn; const LAS float* s = scr + (8 * c) * 33 + nn;
        v4u o; o.x = pk2(s[0 * 33], s[1 * 33]); o.y = pk2(s[2 * 33], s[3 * 33]); o.z = pk2(s[4 * 33], s[5 * 33]); o.w = pk2(s[6 * 33], s[7 * 33]);
        int dr = row_off + n; if (mode) dr = ((n >> 7) << 8) + (n & 127) + (mode == 2 ? 128 : 0);
        if (n < N && k0 + 8 * c + 8 <= ldt) *(v4u*)(WT + (size_t)dr * ldt + k0 + 8 * c) = o; }
    LDS_WAIT();
}
struct TrJob { const float* W; bf16* WT; int K, N, ldt, row_off, mode, nnb, start, pad; };
constexpr int PRO_JOBS_OFF = 140000;
DI void prologue(KA a, LAS unsigned char* lds) {
    const int tid = tid_(), lane = tid & 63, wave = tid >> 6, gw = blockIdx.x * NWAVES + wave, ngw = gridDim.x * NWAVES;
    LAS float* scr = (LAS float*)(lds + wave * 16384);
    unsigned char* ws = a->ws;
    LAS TrJob* jobs = (LAS TrJob*)(lds + PRO_JOBS_OFF); LAS int* njobs = (LAS int*)(lds + PRO_JOBS_OFF + 48 * 40);
    if (tid == 0) { int nj = 0, st = 0;
#define ADDJOB(W_, K_, N_, WT_, LDT_, RO_, MODE_) do { const int nkb_ = (((K_) > (LDT_) ? (K_) : (LDT_)) + 63) / 64, nnb_ = ((N_) + 31) / 32; \
        jobs[nj].W = (W_); jobs[nj].WT = (WT_); jobs[nj].K = (K_); jobs[nj].N = (N_); jobs[nj].ldt = (LDT_); jobs[nj].row_off = (RO_); jobs[nj].mode = (MODE_); jobs[nj].nnb = nnb_; jobs[nj].start = st; st += nkb_ * nnb_; ++nj; } while (0)
        for (int l = 0; l < 2; ++l) {
            bf16* winT = (bf16*)(ws + WS_WIN + l * WIN_STRIDE); unsigned char* sm = ws + WS_SMALL + l * SMALL_STRIDE;
            ADDJOB(a->in[I_WIN] + (size_t)l * D * 3400, D, 3400, winT, D, 0, 0);
            if (l == 1) ADDJOB(a->in[I_WINV], D, 32, winT, D, 3400, 0);
            ADDJOB(a->in[I_WOUT] + (size_t)l * D * D, D, D, (bf16*)(ws + WS_WOUT + l * WOUT_STRIDE), D, 0, 0);
            ADDJOB(a->in[I_FG] + (size_t)l * D * FF, D, FF, (bf16*)(ws + WS_WGU + l * WGU_STRIDE), D, 0, 1);
            ADDJOB(a->in[I_FU] + (size_t)l * D * FF, D, FF, (bf16*)(ws + WS_WGU + l * WGU_STRIDE), D, 0, 2);
            ADDJOB(a->in[I_FD] + (size_t)l * FF * D, FF, D, (bf16*)(ws + WS_WD + l * WD_STRIDE), FF, 0, 0);
            ADDJOB(a->in[I_WK1] + (size_t)l * 2048 * 256, 2048, 256, (bf16*)(ws + WS_WC1 + (l * 2 + 0) * MiB), 2048, 0, 0);
            ADDJOB(a->in[I_WV1] + (size_t)l * 2048 * 256, 2048, 256, (bf16*)(ws + WS_WC1 + (l * 2 + 1) * MiB), 2048, 0, 0);
            ADDJOB(a->in[I_W2] + (size_t)l * 64 * 256, 64, 256, (bf16*)(sm + SM_W2T), 64, 0, 0);
            ADDJOB(a->in[I_A2] + (size_t)l * 64 * 256, 64, 256, (bf16*)(sm + SM_A2T), 64, 0, 0);
            ADDJOB(a->in[I_G2] + (size_t)l * 160 * 256, 160, 256, (bf16*)(sm + SM_G2T), 192, 0, 0);
            if (l == 1) ADDJOB(a->in[I_V2], 32, 256, (bf16*)(sm + SM_V2T), 64, 0, 0);
            ADDJOB(a->in[I_WK2] + (size_t)l * 256 * 64, 256, 64, (bf16*)(sm + SM_WK2T), 256, 0, 0);
            ADDJOB(a->in[I_WV2] + (size_t)l * 256 * 64, 256, 64, (bf16*)(sm + SM_WV2T), 256, 0, 0);
        }
#undef ADDJOB
        jobs[nj].start = st; *njobs = nj; }
    __syncthreads();
    { const int nj = *njobs, total = jobs[nj].start;
      for (int it = gw; it < total; it += 2 * ngw) {
          const int itB = it + ngw; const bool hasB = itB < total;
          int jA = 0; while (jA + 1 < nj && jobs[jA + 1].start <= it) ++jA;
          int jB = jA; if (hasB) { while (jB + 1 < nj && jobs[jB + 1].start <= itB) ++jB; }
          const int rA = it - jobs[jA].start, nnbA = jobs[jA].nnb, rB = hasB ? itB - jobs[jB].start : 0, nnbB = jobs[jB].nnb;
          float vA[32], vB[32];
          tr_load(vA, jobs[jA].W, jobs[jA].K, jobs[jA].N, rA / nnbA, rA % nnbA, lane);
          if (hasB) tr_load(vB, jobs[jB].W, jobs[jB].K, jobs[jB].N, rB / nnbB, rB % nnbB, lane);
          tr_finish(vA, jobs[jA].N, jobs[jA].WT, jobs[jA].ldt, jobs[jA].row_off, jobs[jA].mode, rA / nnbA, rA % nnbA, scr, lane);
          if (hasB) tr_finish(vB, jobs[jB].N, jobs[jB].WT, jobs[jB].ldt, jobs[jB].row_off, jobs[jB].mode, rB / nnbB, rB % nnbB, scr, lane); } }
    for (int l = 0; l < 2; ++l) { bf16* winT = (bf16*)(ws + WS_WIN + l * WIN_STRIDE); const int r0 = (l == 1) ? 3432 : 3400; const int nchunk = (HP - r0) * (D / 8);
        for (int i = blockIdx.x * NTHR + tid; i < nchunk; i += gridDim.x * NTHR) *(v4u*)(winT + (size_t)r0 * D + (size_t)i * 8) = (v4u){0u, 0u, 0u, 0u}; }
#ifndef REP_ROPE
#define REP_ROPE 1
#endif
    for (int rr_ = 0; rr_ < REP_ROPE; ++rr_)
    { float* ct = (float*)(ws + WS_COS); float* st = (float*)(ws + WS_SIN);
      for (int i = blockIdx.x * NTHR + tid; i < SEQ * 32; i += gridDim.x * NTHR) { const int pos = i >> 5, f = i & 31;
          const float inv = powf(10000.f, -(float)f / 32.f); const float ang = (float)pos * inv; ct[i] = (float)cos((double)ang); st[i] = (float)sin((double)ang); } }
    { const float* x = a->in[I_X]; bf16* act = (bf16*)(ws + WS_ACT); const size_t stride = (size_t)gridDim.x * NTHR, n8 = (size_t)T * D / 8;
      for (size_t i = (size_t)blockIdx.x * NTHR + tid; i < n8; i += 4 * stride) { f32x4 v0[4], v1[4];
#pragma unroll
          for (int u = 0; u < 4; ++u) { const size_t ii = i + u * stride; if (ii < n8) { v0[u] = *(const f32x4*)(x + ii * 8); v1[u] = *(const f32x4*)(x + ii * 8 + 4); } }
#pragma unroll
          for (int u = 0; u < 4; ++u) { const size_t ii = i + u * stride; if (ii < n8) { v4u o; o.x = pk2(v0[u][0], v0[u][1]); o.y = pk2(v0[u][2], v0[u][3]); o.z = pk2(v1[u][0], v1[u][1]); o.w = pk2(v1[u][2], v1[u][3]); *(v4u*)(act + ii * 8) = o; } } } }
}
DI void ln_phase(float* io, bf16* act, const float* w, const float* b, const bool wr_f32, const bool wr_bf16) {
    const int tid = tid_(), lane = tid & 63, gw = blockIdx.x * NWAVES + (tid >> 6), ngw = gridDim.x * NWAVES;
    f32x4 nv[4];
    if (gw < T) { const f32x4* x0 = (const f32x4*)(io + (size_t)gw * D) + lane;
#pragma unroll
        for (int j = 0; j < 4; ++j) nv[j] = x0[64 * j]; }
    for (int r = gw; r < T; r += ngw) {
        f32x4* xr = (f32x4*)(io + (size_t)r * D) + lane; f32x4 v[4]; float s = 0.f;
#pragma unroll
        for (int j = 0; j < 4; ++j) { v[j] = nv[j]; s += (v[j][0] + v[j][1]) + (v[j][2] + v[j][3]); }
        if (r + ngw < T) { const f32x4* xn = (const f32x4*)(io + (size_t)(r + ngw) * D) + lane;
#pragma unroll
            for (int j = 0; j < 4; ++j) nv[j] = xn[64 * j]; }
        const float mean = wave_sum(s) * (1.f / D); float s2 = 0.f;
#pragma unroll
        for (int j = 0; j < 4; ++j) { v[j] = v[j] - mean; s2 += (v[j][0] * v[j][0] + v[j][1] * v[j][1]) + (v[j][2] * v[j][2] + v[j][3] * v[j][3]); }
        const float rstd = 1.f / sqrtf(wave_sum(s2) * (1.f / D) + LN_EPS);
        v2u* o8 = (v2u*)(act + (size_t)r * D) + lane;
#pragma unroll
        for (int j = 0; j < 4; ++j) { const f32x4 wv = ((const f32x4*)w)[lane + 64 * j], bv = ((const f32x4*)b)[lane + 64 * j];
            f32x4 y; y[0] = v[j][0] * rstd * wv[0] + bv[0]; y[1] = v[j][1] * rstd * wv[1] + bv[1]; y[2] = v[j][2] * rstd * wv[2] + bv[2]; y[3] = v[j][3] * rstd * wv[3] + bv[3];
            if (wr_f32) xr[64 * j] = y; if (wr_bf16) { v2u p; p.x = pk2(y[0], y[1]); p.y = pk2(y[2], y[3]); o8[64 * j] = p; } }
    }
}
#define XB_TMO      128
#define XB_XCNT(j)  (256  + 64 * (j))
#define XB_XSUB(j)  (1280 + 64 * (j))
#define XB_XGEN(j)  (2304 + 64 * (j))
#define XB_TOP      3328
#define XB_TOPGEN   3392
#define XCD_BAR_WORDS 3456
#define XB_SPIN_CAP (1u << 18)

__device__ __forceinline__ unsigned xb_ld(unsigned* p)              { return __hip_atomic_load(p, __ATOMIC_RELAXED, __HIP_MEMORY_SCOPE_AGENT); }
__device__ __forceinline__ unsigned xb_add(unsigned* p, unsigned v) { return __hip_atomic_fetch_add(p, v, __ATOMIC_RELAXED, __HIP_MEMORY_SCOPE_AGENT); }
__device__ __forceinline__ unsigned xb_xcc_id() { return (unsigned)__builtin_amdgcn_s_getreg((3 << 11) | 20) & 0xFu; }
#define XB_SPIN(cond, bar) do { unsigned _sp = 0; while (cond) { __builtin_amdgcn_s_sleep(1); \
    if ((++_sp & 255u) == 0u) { if (xb_ld(&(bar)[XB_TMO])) break; if (_sp > XB_SPIN_CAP) { atomicAdd(&(bar)[XB_TMO], 1u); break; } } } } while (0)

struct XcdBarrier {
    unsigned* bar; unsigned x;
    volatile LAS unsigned* st;
};

__device__ __forceinline__ XcdBarrier xcd_barrier_post(unsigned* bar, volatile LAS unsigned* st) {
    XcdBarrier b; b.bar = bar; b.x = xb_xcc_id(); b.st = st;
    if (threadIdx.x == 0) (void)xb_add(&bar[XB_XCNT(b.x)], 1u);
    return b;
}
__device__ __forceinline__ void xcd_barrier_complete(unsigned* bar, unsigned x, unsigned& nloc, unsigned& nx) {
    const unsigned G = gridDim.x * gridDim.y * gridDim.z;
    unsigned sum, cnt, mine, sp = 0u;
    for (;;) {
        sum = 0u; cnt = 0u; mine = 0u;
#pragma unroll
        for (unsigned j = 0; j < 16; ++j) { const unsigned c = xb_ld(&bar[XB_XCNT(j)]); sum += c; cnt += (c > 0u) ? 1u : 0u; mine = (j == x) ? c : mine; }
        if (sum == G) break;
        __builtin_amdgcn_s_sleep(1);
        if ((++sp & 255u) == 0u) { if (xb_ld(&bar[XB_TMO])) break; if (sp > XB_SPIN_CAP) { atomicAdd(&bar[XB_TMO], 1u); break; } }
    }
    nloc = mine > 0u ? mine : 1u; nx = cnt > 0u ? cnt : 1u;
}

__device__ __forceinline__ void xcd_barrier(const XcdBarrier& b) {
    asm volatile("s_waitcnt vmcnt(0)" ::: "memory");
    __syncthreads();
    if (threadIdx.x == 0) {
        unsigned* bar = b.bar;
        __builtin_amdgcn_s_waitcnt(0);
        unsigned nloc = b.st[0], nx = b.st[1];
        if (nloc == 0u) { xcd_barrier_complete(bar, b.x, nloc, nx); b.st[0] = nloc; b.st[1] = nx; }
        const unsigned old = xb_add(&bar[XB_XSUB(b.x)], 1u);
        const unsigned gen = old / nloc;
        if (old + 1u == (gen + 1u) * nloc) {
            __builtin_amdgcn_fence(__ATOMIC_RELEASE, "agent");
            asm volatile("s_waitcnt vmcnt(0)" ::: "memory");
            const unsigned og = xb_add(&bar[XB_TOP], 1u);
            const unsigned tg = og / nx;
            if (og + 1u == (tg + 1u) * nx) xb_add(&bar[XB_TOPGEN], 1u);
            else XB_SPIN(xb_ld(&bar[XB_TOPGEN]) == tg, bar);
            __builtin_amdgcn_fence(__ATOMIC_ACQUIRE, "agent");
            xb_add(&bar[XB_XGEN(b.x)], 1u);
            asm volatile("s_waitcnt vmcnt(0)" ::: "memory");
        } else {
            XB_SPIN(xb_ld(&bar[XB_XGEN(b.x)]) == gen, bar);
            __builtin_amdgcn_fence(__ATOMIC_ACQUIRE, "agent");
            asm volatile("s_waitcnt vmcnt(0)" ::: "memory");
        }
    }
    __syncthreads();
}
DI f32x4 mma16(bf16x8 a, bf16x8 b, f32x4 c) { return __builtin_amdgcn_mfma_f32_16x16x32_bf16(a, b, c, 0, 0, 0); }
DI f32x16 mma32(bf16x8 a, bf16x8 b, f32x16 c) { return __builtin_amdgcn_mfma_f32_32x32x16_bf16(a, b, c, 0, 0, 0); }
DI void unpack8(const v4u u, float (&f)[8]) { f[0] = bflo(u.x); f[1] = bfhi(u.x); f[2] = bflo(u.y); f[3] = bfhi(u.y); f[4] = bflo(u.z); f[5] = bfhi(u.z); f[6] = bflo(u.w); f[7] = bfhi(u.w); }
DI v4u pack8(const float (&f)[8]) { v4u o; o.x = pk2(f[0], f[1]); o.y = pk2(f[2], f[3]); o.z = pk2(f[4], f[5]); o.w = pk2(f[6], f[7]); return o; }
DI float ldbf(const bf16* p) { return bf2f(*p); }
constexpr int PA = 72;
#define ZERO4 ((f32x4){0.f, 0.f, 0.f, 0.f})
DI float red16(float v) { v += __shfl_xor(v, 1); v += __shfl_xor(v, 2); v += __shfl_xor(v, 4); v += __shfl_xor(v, 8); return v; }

DI void rwkv_prep_item(KA a, const int l, LAS unsigned char* lds, const int tile) {
    const int tid = tid_(), lane = tid & 63, w = tid >> 6, fr = lane & 15, fq = lane >> 4;
    unsigned char* ws = a->ws;
    const bf16* H = (const bf16*)(ws + WS_H);
    LAS bf16* Aw = (LAS bf16*)lds; LAS bf16* Aa = Aw + 64 * PA; LAS bf16* Av = Aa + 64 * PA;
    const int t0 = tile * 64;
    const float* mu = a->in[I_MU] + l * 1056;
    __syncthreads();
    {   const int tk = tid >> 3, c0 = (tid & 7) * 8, t = t0 + tk; const bool first = (t & (SEQ - 1)) == 0;
        const bf16* hr = H + (size_t)t * HP;
        float cu[8], pv[8], o[8];
        unpack8(*(const v4u*)(hr + C_RWL + c0), cu); if (first) { for (int e = 0; e < 8; ++e) pv[e] = 0.f; } else unpack8(*(const v4u*)(hr - HP + C_RWL + c0), pv);
#pragma unroll
        for (int e = 0; e < 8; ++e) o[e] = fast_tanh(cu[e] + (pv[e] - cu[e]) * mu[768 + c0 + e]);
        *(LAS v4u*)(Aw + tk * PA + c0) = pack8(o);
        unpack8(*(const v4u*)(hr + C_RAL + c0), cu); if (first) { for (int e = 0; e < 8; ++e) pv[e] = 0.f; } else unpack8(*(const v4u*)(hr - HP + C_RAL + c0), pv);
#pragma unroll
        for (int e = 0; e < 8; ++e) o[e] = cu[e] + (pv[e] - cu[e]) * mu[832 + c0 + e];
        *(LAS v4u*)(Aa + tk * PA + c0) = pack8(o);
        if (l == 1 && (tid & 7) < 4) { const float* muv = a->in[I_MUV];
            unpack8(*(const v4u*)(hr + C_VR + c0), cu); if (first) { for (int e = 0; e < 8; ++e) pv[e] = 0.f; } else unpack8(*(const v4u*)(hr - HP + C_VR + c0), pv);
#pragma unroll
            for (int e = 0; e < 8; ++e) o[e] = cu[e] + (pv[e] - cu[e]) * muv[c0 + e];
            *(LAS v4u*)(Av + tk * PA + c0) = pack8(o); }
    }
    __syncthreads();
    const int hd = w >> 1, th = w & 1;
    f32x4 accw[4][2], acca[4][2], accv[4][2];
#pragma unroll
    for (int ct = 0; ct < 4; ++ct)
#pragma unroll
        for (int rt = 0; rt < 2; ++rt) { accw[ct][rt] = ZERO4; acca[ct][rt] = ZERO4; accv[ct][rt] = ZERO4; }
    const bf16* w2T = (const bf16*)(ws + WS_SMALL + l * SMALL_STRIDE + SM_W2T); const bf16* a2T = (const bf16*)(ws + WS_SMALL + l * SMALL_STRIDE + SM_A2T); const bf16* v2T = (const bf16*)(ws + WS_SMALL + l * SMALL_STRIDE + SM_V2T);
#pragma unroll
    for (int ks = 0; ks < 2; ++ks) {
        bf16x8 afw[2], afa[2];
#pragma unroll
        for (int rt = 0; rt < 2; ++rt) { afw[rt] = *(const LAS bf16x8*)(Aw + (32 * th + 16 * rt + fr) * PA + ks * 32 + fq * 8); afa[rt] = *(const LAS bf16x8*)(Aa + (32 * th + 16 * rt + fr) * PA + ks * 32 + fq * 8); }
#pragma unroll
        for (int ct = 0; ct < 4; ++ct) { const size_t ro = (size_t)(hd * 64 + ct * 16 + fr) * 64 + ks * 32 + fq * 8;
            const bf16x8 bw = *(const bf16x8*)(w2T + ro), ba = *(const bf16x8*)(a2T + ro);
#pragma unroll
            for (int rt = 0; rt < 2; ++rt) { accw[ct][rt] = mma16(bw, afw[rt], accw[ct][rt]); acca[ct][rt] = mma16(ba, afa[rt], acca[ct][rt]); } }
    }
    if (l == 1) {
        bf16x8 afv[2];
#pragma unroll
        for (int rt = 0; rt < 2; ++rt) afv[rt] = *(const LAS bf16x8*)(Av + (32 * th + 16 * rt + fr) * PA + fq * 8);
#pragma unroll
        for (int ct = 0; ct < 4; ++ct) { const bf16x8 bv = *(const bf16x8*)(v2T + (size_t)(hd * 64 + ct * 16 + fr) * 64 + fq * 8);
#pragma unroll
            for (int rt = 0; rt < 2; ++rt) accv[ct][rt] = mma16(bv, afv[rt], accv[ct][rt]); }
    }
    const float* w0 = a->in[I_W0] + l * 256; const float* a0 = a->in[I_A0] + l * 256; const float* kkw = a->in[I_KK] + l * 256; const float* kaw = a->in[I_KA] + l * 256; const float* v0 = a->in[I_V0];
    float kx[2][4][4], ss[2] = {0.f, 0.f};
#pragma unroll
    for (int rt = 0; rt < 2; ++rt) { const int tk = t0 + 32 * th + 16 * rt + fr; const bool first = (tk & (SEQ - 1)) == 0;
#pragma unroll
        for (int ct = 0; ct < 4; ++ct) { const int c4 = hd * 64 + ct * 16 + 4 * fq; const f32x4 muk = *(const f32x4*)(mu + 256 + c4), kk4 = *(const f32x4*)(kkw + c4);
            const bf16* hp = H + (size_t)tk * HP + C_RK + c4; const v2u cu = *(const v2u*)hp; v2u pv = {0u, 0u}; if (!first) pv = *(const v2u*)(hp - HP);
            const float c_[4] = {bflo(cu.x), bfhi(cu.x), bflo(cu.y), bfhi(cu.y)}, p_[4] = {bflo(pv.x), bfhi(pv.x), bflo(pv.y), bfhi(pv.y)};
#pragma unroll
            for (int j = 0; j < 4; ++j) { const float k = c_[j] + (p_[j] - c_[j]) * muk[j]; kx[rt][ct][j] = k; const float kk = k * kk4[j]; ss[rt] += kk * kk; } } }
#pragma unroll
    for (int rt = 0; rt < 2; ++rt) { float s_ = ss[rt]; s_ += __shfl_xor(s_, 16); s_ += __shfl_xor(s_, 32); ss[rt] = 1.f / fmaxf(sqrtf(s_), 1e-12f); }
    float* Rw = (float*)(ws + WS_RW); bf16* Rr = (bf16*)(ws + WS_RR); bf16* Rk = (bf16*)(ws + WS_RK); bf16* Rv = (bf16*)(ws + WS_RV); bf16* Ra = (bf16*)(ws + WS_RA); bf16* Rb = (bf16*)(ws + WS_RB); bf16* VF = (bf16*)(ws + WS_VF);
#pragma unroll
    for (int rt = 0; rt < 2; ++rt) { const int tk = t0 + 32 * th + 16 * rt + fr; const bool first = (tk & (SEQ - 1)) == 0;
#pragma unroll
        for (int ct = 0; ct < 4; ++ct) { const int c4 = hd * 64 + ct * 16 + 4 * fq; const size_t ro = (size_t)tk * 256 + c4;
            const f32x4 mur = *(const f32x4*)(mu + c4), muv4 = *(const f32x4*)(mu + 512 + c4), w04 = *(const f32x4*)(w0 + c4), a04 = *(const f32x4*)(a0 + c4), kk4 = *(const f32x4*)(kkw + c4), ka4 = *(const f32x4*)(kaw + c4);
            f32x4 v04 = ZERO4; if (l == 1) v04 = *(const f32x4*)(v0 + c4);
            const bf16* hpr = H + (size_t)tk * HP + C_RR + c4; const bf16* hpv = H + (size_t)tk * HP + C_RV + c4;
            const v2u cr = *(const v2u*)hpr, cv = *(const v2u*)hpv; v2u pr = {0u, 0u}, pvv = {0u, 0u}; if (!first) { pr = *(const v2u*)(hpr - HP); pvv = *(const v2u*)(hpv - HP); }
            v2u vf2 = {0u, 0u}; if (l == 1) vf2 = *(const v2u*)(VF + ro);
            const float cr_[4] = {bflo(cr.x), bfhi(cr.x), bflo(cr.y), bfhi(cr.y)}, pr_[4] = {bflo(pr.x), bfhi(pr.x), bflo(pr.y), bfhi(pr.y)};
            const float cv_[4] = {bflo(cv.x), bfhi(cv.x), bflo(cv.y), bfhi(cv.y)}, pv_[4] = {bflo(pvv.x), bfhi(pvv.x), bflo(pvv.y), bfhi(pvv.y)}, vf_[4] = {bflo(vf2.x), bfhi(vf2.x), bflo(vf2.y), bfhi(vf2.y)};
            float o_r[4], o_k[4], o_v[4], o_a[4], o_b[4]; f32x4 o_w;
#pragma unroll
            for (int j = 0; j < 4; ++j) { const float r = cr_[j] + (pr_[j] - cr_[j]) * mur[j]; float v = cv_[j] + (pv_[j] - cv_[j]) * muv4[j];
                if (l == 1) v = v + (vf_[j] - v) * sigmoidf_(v04[j] + accv[ct][rt][j]);
                const float av = sigmoidf_(a04[j] + acca[ct][rt][j]);
                o_w[j] = __expf(-0.6065306597126334f * sigmoidf_(w04[j] + accw[ct][rt][j]));
                const float k = kx[rt][ct][j]; const float kkn = k * kk4[j] * ss[rt];
                o_r[j] = r; o_k[j] = k * (1.f + (av - 1.f) * ka4[j]); o_v[j] = v; o_a[j] = -kkn; o_b[j] = kkn * av; }
            *(f32x4*)(Rw + ro) = o_w;
#define ST4(P_, A_) do { v2u q_; q_.x = pk2(A_[0], A_[1]); q_.y = pk2(A_[2], A_[3]); *(v2u*)((P_) + ro) = q_; } while (0)
            ST4(Rr, o_r); ST4(Rk, o_k); ST4(Rv, o_v); ST4(Ra, o_a); ST4(Rb, o_b); if (l == 0) ST4(VF, o_v);
        } }
}

template <int CTRL> DI float ror_add(float x) { return x + __builtin_bit_cast(float, __builtin_amdgcn_update_dpp(0, __builtin_bit_cast(int, x), CTRL, 0xF, 0xF, true)); }
DI float allred16(float d) { d = ror_add<0x128>(d); d = ror_add<0x124>(d); d = ror_add<0x122>(d); d = ror_add<0x121>(d); return d; }
constexpr int SC = 32;
constexpr int SBUF_F = 5 * SC * 64 + SC * 32;
DI void rwkv_scan_item(KA a, LAS unsigned char* lds, const int item) {
    const int tid = tid_(), lane = tid & 63, w = tid >> 6, kl = lane & 15, rowl = w * 4 + (lane >> 4);
    const int half = item & 1, bh = item >> 1, hd = bh & 3, b = bh >> 2;
    unsigned char* ws = a->ws;
    const float* Rw = (const float*)(ws + WS_RW); const bf16* Rr = (const bf16*)(ws + WS_RR); const bf16* Rk = (const bf16*)(ws + WS_RK); const bf16* Rv = (const bf16*)(ws + WS_RV); const bf16* Ra = (const bf16*)(ws + WS_RA); const bf16* Rb = (const bf16*)(ws + WS_RB);
    bf16* H = (bf16*)(ws + WS_H);
    LAS float* sb = (LAS float*)lds;
    LAS float* yb = sb + 2 * SBUF_F;
    const int stk = tid >> 4, spart = tid & 15;
    const size_t gbase = (size_t)b * SEQ * 256 + hd * 64;
    f32x4 gw; v2u gr, gk, ga, gb; unsigned gv;
#define RW_LOAD(c) do { const size_t o_ = gbase + (size_t)((c) * SC + stk) * 256 + 4 * spart; gw = *(const f32x4*)(Rw + o_); gr = *(const v2u*)(Rr + o_); gk = *(const v2u*)(Rk + o_); ga = *(const v2u*)(Ra + o_); gb = *(const v2u*)(Rb + o_); \
        gv = *(const unsigned*)(Rv + gbase + (size_t)((c) * SC + stk) * 256 + half * 32 + 2 * spart); } while (0)
#define RW_STORE(bufi) do { LAS float* d_ = sb + (bufi) * SBUF_F; const int o_ = stk * 64 + 4 * spart; \
        *(LAS f32x4*)(d_ + o_) = (f32x4){bflo(gr.x), bfhi(gr.x), bflo(gr.y), bfhi(gr.y)}; *(LAS f32x4*)(d_ + SC * 64 + o_) = gw; \
        *(LAS f32x4*)(d_ + 2 * SC * 64 + o_) = (f32x4){bflo(gk.x), bfhi(gk.x), bflo(gk.y), bfhi(gk.y)}; *(LAS f32x4*)(d_ + 3 * SC * 64 + o_) = (f32x4){bflo(ga.x), bfhi(ga.x), bflo(ga.y), bfhi(ga.y)}; \
        *(LAS f32x4*)(d_ + 4 * SC * 64 + o_) = (f32x4){bflo(gb.x), bfhi(gb.x), bflo(gb.y), bfhi(gb.y)}; *(LAS f32x2*)(d_ + 5 * SC * 64 + stk * 32 + 2 * spart) = (f32x2){bflo(gv), bfhi(gv)}; } while (0)
    __syncthreads();
    RW_LOAD(0); RW_STORE(0);
    __syncthreads();
    f32x2 sA = {0.f, 0.f}, sB = {0.f, 0.f};
    constexpr int NCH = SEQ / SC;
    for (int c = 0; c < NCH; ++c) {
        if (c + 1 < NCH) RW_LOAD(c + 1);
        if (c > 0) {
            const LAS float* ys = yb + ((c - 1) & 1) * SC * 32 + (2 * spart) * SC + stk;
            *(unsigned*)(H + ((size_t)b * SEQ + (size_t)(c - 1) * SC + stk) * HP + C_RR + hd * 64 + half * 32 + 2 * spart) = pk2(ys[0], ys[SC]);
        }
        const LAS float* d_ = sb + (c & 1) * SBUF_F; LAS float* yo = yb + (c & 1) * SC * 32;
        for (int t4 = 0; t4 < SC; t4 += 4) {
            f32x4 R4[4], W4[4], K4[4], A4[4], B4[4]; float V1[4], yv[4];
#pragma unroll
            for (int u = 0; u < 4; ++u) { const int tt = t4 + u;
                R4[u] = *(const LAS f32x4*)(d_ + tt * 64 + 4 * kl); W4[u] = *(const LAS f32x4*)(d_ + SC * 64 + tt * 64 + 4 * kl); K4[u] = *(const LAS f32x4*)(d_ + 2 * SC * 64 + tt * 64 + 4 * kl);
                A4[u] = *(const LAS f32x4*)(d_ + 3 * SC * 64 + tt * 64 + 4 * kl); B4[u] = *(const LAS f32x4*)(d_ + 4 * SC * 64 + tt * 64 + 4 * kl); V1[u] = d_[5 * SC * 64 + tt * 32 + rowl]; }
#pragma unroll
            for (int u = 0; u < 4; ++u) {
                const f32x2 a01 = {A4[u][0], A4[u][1]}, a23 = {A4[u][2], A4[u][3]}, b01 = {B4[u][0], B4[u][1]}, b23 = {B4[u][2], B4[u][3]};
                const f32x2 k01 = {K4[u][0], K4[u][1]}, k23 = {K4[u][2], K4[u][3]}, w01 = {W4[u][0], W4[u][1]}, w23 = {W4[u][2], W4[u][3]}, r01 = {R4[u][0], R4[u][1]}, r23 = {R4[u][2], R4[u][3]};
                f32x2 p = sA * a01; p = sB * a23 + p;
                const float dsa = allred16(p[0] + p[1]);
                const f32x2 tA = k01 * V1[u] + b01 * dsa, tB = k23 * V1[u] + b23 * dsa;
                sA = sA * w01 + tA; sB = sB * w23 + tB;
                f32x2 q = sA * r01; q = sB * r23 + q;
                yv[u] = q[0] + q[1];
            }
#pragma unroll
            for (int u = 0; u < 4; ++u) yv[u] = ror_add<0x128>(yv[u]);
#pragma unroll
            for (int u = 0; u < 4; ++u) yv[u] = ror_add<0x124>(yv[u]);
#pragma unroll
            for (int u = 0; u < 4; ++u) yv[u] = ror_add<0x122>(yv[u]);
#pragma unroll
            for (int u = 0; u < 4; ++u) yv[u] = ror_add<0x121>(yv[u]);
            if (kl == 0) *(LAS f32x4*)(yo + rowl * SC + t4) = (f32x4){yv[0], yv[1], yv[2], yv[3]};
        }
        if (c + 1 < NCH) RW_STORE((c + 1) & 1);
        __syncthreads();
    }
    {   const LAS float* ys = yb + ((NCH - 1) & 1) * SC * 32 + (2 * spart) * SC + stk;
        *(unsigned*)(H + ((size_t)b * SEQ + (size_t)(NCH - 1) * SC + stk) * HP + C_RR + hd * 64 + half * 32 + 2 * spart) = pk2(ys[0], ys[SC]); }
#undef RW_LOAD
#undef RW_STORE
}

constexpr int PG = 168;
DI void rwkv_post_item(KA a, const int l, LAS unsigned char* lds, const int tile) {
    const int tid = tid_(), lane = tid & 63, w = tid >> 6, fr = lane & 15, fq = lane >> 4;
    unsigned char* ws = a->ws;
    const bf16* H = (const bf16*)(ws + WS_H);
    LAS bf16* Ag = (LAS bf16*)lds;
    const int t0 = tile * 64;
    const float* mu = a->in[I_MU] + l * 1056;
    __syncthreads();
    for (int idx = tid; idx < 64 * 20; idx += NTHR) { const int tk = idx / 20, c0 = (idx % 20) * 8, t = t0 + tk; const bool first = (t & (SEQ - 1)) == 0;
        const bf16* hr = H + (size_t)t * HP; float cu[8], pv[8], o[8];
        unpack8(*(const v4u*)(hr + C_RGL + c0), cu); if (first) { for (int e = 0; e < 8; ++e) pv[e] = 0.f; } else unpack8(*(const v4u*)(hr - HP + C_RGL + c0), pv);
#pragma unroll
        for (int e = 0; e < 8; ++e) o[e] = sigmoidf_(cu[e] + (pv[e] - cu[e]) * mu[896 + c0 + e]);
        *(LAS v4u*)(Ag + tk * PG + c0) = pack8(o); }
    __syncthreads();
    const int hd = w >> 1, th = w & 1;
    f32x4 accg[4][2];
#pragma unroll
    for (int ct = 0; ct < 4; ++ct) { accg[ct][0] = ZERO4; accg[ct][1] = ZERO4; }
    const bf16* g2T = (const bf16*)(ws + WS_SMALL + l * SMALL_STRIDE + SM_G2T);
#pragma unroll
    for (int ks = 0; ks < 5; ++ks) {
        bf16x8 af[2];
#pragma unroll
        for (int rt = 0; rt < 2; ++rt) af[rt] = *(const LAS bf16x8*)(Ag + (32 * th + 16 * rt + fr) * PG + ks * 32 + fq * 8);
#pragma unroll
        for (int ct = 0; ct < 4; ++ct) { const bf16x8 bg = *(const bf16x8*)(g2T + (size_t)(hd * 64 + ct * 16 + fr) * 192 + ks * 32 + fq * 8);
#pragma unroll
            for (int rt = 0; rt < 2; ++rt) accg[ct][rt] = mma16(bg, af[rt], accg[ct][rt]); }
    }
    const bf16* Rr = (const bf16*)(ws + WS_RR); const bf16* Rk = (const bf16*)(ws + WS_RK); const bf16* Rv = (const bf16*)(ws + WS_RV);
    const float* rkw = a->in[I_RK] + l * 256; const float* lnw = a->in[I_RLNW] + l * 256; const float* lnb = a->in[I_RLNB] + l * 256;
    bf16* act = (bf16*)(ws + WS_ACT);
#pragma unroll
    for (int rt = 0; rt < 2; ++rt) { const int tk = t0 + 32 * th + 16 * rt + fr;
        float y[4][4], sy = 0.f, srk = 0.f;
#pragma unroll
        for (int ct = 0; ct < 4; ++ct) { const int c4 = hd * 64 + ct * 16 + 4 * fq; const size_t ro = (size_t)tk * 256 + c4; const f32x4 rk4 = *(const f32x4*)(rkw + c4);
            const v2u yy = *(const v2u*)(H + (size_t)tk * HP + C_RR + c4), r2 = *(const v2u*)(Rr + ro), k2 = *(const v2u*)(Rk + ro);
            const float y_[4] = {bflo(yy.x), bfhi(yy.x), bflo(yy.y), bfhi(yy.y)}, r_[4] = {bflo(r2.x), bfhi(r2.x), bflo(r2.y), bfhi(r2.y)}, k_[4] = {bflo(k2.x), bfhi(k2.x), bflo(k2.y), bfhi(k2.y)};
#pragma unroll
            for (int j = 0; j < 4; ++j) { y[ct][j] = y_[j]; sy += y_[j]; srk += r_[j] * k_[j] * rk4[j]; } }
        sy += __shfl_xor(sy, 16); sy += __shfl_xor(sy, 32); srk += __shfl_xor(srk, 16); srk += __shfl_xor(srk, 32);
        const float mean = sy * (1.f / 64.f); float q = 0.f;
#pragma unroll
        for (int ct = 0; ct < 4; ++ct)
#pragma unroll
            for (int j = 0; j < 4; ++j) { const float d = y[ct][j] - mean; q += d * d; }
        q += __shfl_xor(q, 16); q += __shfl_xor(q, 32);
        const float rstd = 1.f / sqrtf(q * (1.f / 64.f) + 64e-5f);
#pragma unroll
        for (int ct = 0; ct < 4; ++ct) { const int c4 = hd * 64 + ct * 16 + 4 * fq; const size_t ro = (size_t)tk * 256 + c4; const f32x4 lw = *(const f32x4*)(lnw + c4), lb = *(const f32x4*)(lnb + c4);
            const v2u v2 = *(const v2u*)(Rv + ro); const float v_[4] = {bflo(v2.x), bfhi(v2.x), bflo(v2.y), bfhi(v2.y)}; float o[4];
#pragma unroll
            for (int j = 0; j < 4; ++j) o[j] = ((y[ct][j] - mean) * rstd * lw[j] + lb[j] + srk * v_[j]) * accg[ct][rt][j];
            v2u p; p.x = pk2(o[0], o[1]); p.y = pk2(o[2], o[3]); *(v2u*)(act + (size_t)tk * D + 256 + c4) = p; }
    }
}

DI void gla_item(KA a, const int l, LAS unsigned char* lds, const int item) {
    const int tid = tid_(), lane = tid & 63, w = tid >> 6, fr = lane & 15, fq = lane >> 4;
    const int b = item >> 2, hh = item & 3;
    unsigned char* ws = a->ws;
    const bf16* H = (const bf16*)(ws + WS_H); bf16* act = (bf16*)(ws + WS_ACT);
    LAS float* LA = (LAS float*)lds; LAS float* OUTF = LA + 4096; LAS float* WA2 = OUTF + 4096; LAS float* BA = WA2 + 1024; LAS float* SEG = BA + 64; LAS float* DEC = SEG + 512;
    LAS bf16* Qt = (LAS bf16*)(lds + 40960); LAS bf16* Kt = Qt + 64 * PA; LAS bf16* KhT = Kt + 64 * PA; LAS bf16* VT = KhT + 64 * PA; LAS bf16* Pm = VT + 64 * PA; LAS bf16* ST = Pm + 64 * PA;
    __syncthreads();
    { const float* wa2 = a->in[I_GLA_A2] + (size_t)l * 16 * 256; const float* ba = a->in[I_GLA_BA] + l * 256;
      for (int i = tid; i < 1024; i += NTHR) WA2[i] = wa2[(i >> 6) * 256 + hh * 64 + (i & 63)];
      if (tid < 64) BA[tid] = ba[hh * 64 + tid];
      for (int i = tid; i < 64 * PA / 2; i += NTHR) ((LAS unsigned*)ST)[i] = 0u; }
    const float* lnw = a->in[I_GLA_LNW] + l * 256 + hh * 64; const float* lnb = a->in[I_GLA_LNB] + l * 256 + hh * 64;
    f32x4 S[2] = {ZERO4, ZERO4};
    const int t = tid >> 3, kg = tid & 7, rt = w & 3, cp = (w >> 2) * 2;
    __syncthreads();
    v4u pq, pk_, pv_, pg_, pa0, pa1;
    { const bf16* hr0 = H + ((size_t)b * SEQ + t) * HP; pq = *(const v4u*)(hr0 + C_GQ + hh * 64 + 8 * kg); pk_ = *(const v4u*)(hr0 + C_GK + hh * 64 + 8 * kg); pv_ = *(const v4u*)(hr0 + C_GV + hh * 64 + 8 * kg);
      pg_ = *(const v4u*)(hr0 + C_GG + hh * 64 + 8 * kg); pa0 = *(const v4u*)(hr0 + C_GA); pa1 = *(const v4u*)(hr0 + C_GA + 8); }
    for (int c = 0; c < SEQ / 64; ++c) {
        const size_t tb = (size_t)b * SEQ + (size_t)c * 64;
        float q8[8], k8[8], v8[8];
        const v4u cg_ = pg_;
        {
            float al[16]; { float tmp[8]; unpack8(pa0, tmp); for (int e = 0; e < 8; ++e) al[e] = tmp[e]; unpack8(pa1, tmp); for (int e = 0; e < 8; ++e) al[8 + e] = tmp[e]; }
            unpack8(pq, q8); unpack8(pk_, k8); unpack8(pv_, v8);
            if (c + 1 < SEQ / 64) { const bf16* hn = H + (tb + 64 + t) * HP; pq = *(const v4u*)(hn + C_GQ + hh * 64 + 8 * kg); pk_ = *(const v4u*)(hn + C_GK + hh * 64 + 8 * kg); pv_ = *(const v4u*)(hn + C_GV + hh * 64 + 8 * kg);
                pg_ = *(const v4u*)(hn + C_GG + hh * 64 + 8 * kg); pa0 = *(const v4u*)(hn + C_GA); pa1 = *(const v4u*)(hn + C_GA + 8); }
#pragma unroll
            for (int e = 0; e < 8; ++e) { float z = BA[8 * kg + e];
#pragma unroll
                for (int j = 0; j < 16; ++j) z += al[j] * WA2[j * 64 + 8 * kg + e];
                LA[t * 64 + 8 * kg + e] = (fminf(z, 0.f) - __logf(1.f + __expf(-fabsf(z)))) * (1.f / 16.f); }
        }
        __syncthreads();
        {
            const int k = tid & 63, sg = tid >> 6; float run = 0.f;
#pragma unroll
            for (int i = 0; i < 8; ++i) { run += LA[(8 * sg + i) * 64 + k]; LA[(8 * sg + i) * 64 + k] = run; }
            SEG[sg * 64 + k] = run;
        }
        __syncthreads();
        {
            const int sg = t >> 3; float qo[8], ko[8];
#pragma unroll
            for (int e = 0; e < 8; ++e) { const int k = 8 * kg + e; float pre = 0.f, tot = 0.f;
#pragma unroll
                for (int s2 = 0; s2 < 8; ++s2) { const float sv = SEG[s2 * 64 + k]; tot += sv; pre += (s2 < sg) ? sv : 0.f; }
                const float bv = LA[t * 64 + k] + pre;
                qo[e] = q8[e] * 0.125f * __expf(bv); ko[e] = k8[e] * __expf(-bv);
                KhT[k * PA + t] = (bf16)f2bf(k8[e] * __expf(tot - bv)); VT[k * PA + t] = (bf16)f2bf(v8[e]);
                if (t == 63) DEC[k] = __expf(tot); }
            *(LAS v4u*)(Qt + t * PA + 8 * kg) = pack8(qo); *(LAS v4u*)(Kt + t * PA + 8 * kg) = pack8(ko);
        }
        __syncthreads();
        f32x4 ao[2] = {ZERO4, ZERO4};
        {
#pragma unroll
            for (int ks = 0; ks < 2; ++ks) { const bf16x8 aq = *(const LAS bf16x8*)(Qt + (16 * rt + fr) * PA + ks * 32 + fq * 8);
#pragma unroll
                for (int i = 0; i < 2; ++i) { const bf16x8 bs = *(const LAS bf16x8*)(ST + (16 * (cp + i) + fr) * PA + ks * 32 + fq * 8); ao[i] = mma16(aq, bs, ao[i]); } }
            f32x4 pp[2] = {ZERO4, ZERO4};
#pragma unroll
            for (int ks = 0; ks < 2; ++ks) { const bf16x8 aq = *(const LAS bf16x8*)(Qt + (16 * rt + fr) * PA + ks * 32 + fq * 8);
#pragma unroll
                for (int i = 0; i < 2; ++i) { const bf16x8 bk = *(const LAS bf16x8*)(Kt + (16 * (cp + i) + fr) * PA + ks * 32 + fq * 8); pp[i] = mma16(aq, bk, pp[i]); } }
#pragma unroll
            for (int i = 0; i < 2; ++i)
#pragma unroll
                for (int j = 0; j < 4; ++j) { const int tr = 16 * rt + 4 * fq + j, sc = 16 * (cp + i) + fr; Pm[tr * PA + sc] = (bf16)f2bf(sc <= tr ? pp[i][j] : 0.f); }
        }
        __syncthreads();
        {
#pragma unroll
            for (int ks = 0; ks < 2; ++ks) { const bf16x8 ap = *(const LAS bf16x8*)(Pm + (16 * rt + fr) * PA + ks * 32 + fq * 8); const bf16x8 ak = *(const LAS bf16x8*)(KhT + (16 * rt + fr) * PA + ks * 32 + fq * 8);
                f32x4 u[2];
#pragma unroll
                for (int i = 0; i < 2; ++i) { const bf16x8 bv = *(const LAS bf16x8*)(VT + (16 * (cp + i) + fr) * PA + ks * 32 + fq * 8); ao[i] = mma16(ap, bv, ao[i]);
                    if (ks == 0) { f32x4 sd; for (int j = 0; j < 4; ++j) sd[j] = S[i][j] * DEC[16 * rt + 4 * fq + j]; S[i] = sd; }
                    S[i] = mma16(ak, bv, S[i]); }
            }
#pragma unroll
            for (int i = 0; i < 2; ++i)
#pragma unroll
                for (int j = 0; j < 4; ++j) OUTF[(16 * rt + 4 * fq + j) * 64 + 16 * (cp + i) + fr] = ao[i][j];
        }
        __syncthreads();
        {
#pragma unroll
            for (int i = 0; i < 2; ++i) { v2u p; p.x = pk2(S[i][0], S[i][1]); p.y = pk2(S[i][2], S[i][3]); *(LAS v2u*)(ST + (16 * (cp + i) + fr) * PA + 16 * rt + 4 * fq) = p; }
            float x[8], sm = 0.f;
#pragma unroll
            for (int e = 0; e < 8; ++e) { x[e] = OUTF[t * 64 + 8 * kg + e]; sm += x[e]; }
            sm += __shfl_xor(sm, 1); sm += __shfl_xor(sm, 2); sm += __shfl_xor(sm, 4);
            const float mean = sm * (1.f / 64.f); float qv = 0.f;
#pragma unroll
            for (int e = 0; e < 8; ++e) { x[e] -= mean; qv += x[e] * x[e]; }
            qv += __shfl_xor(qv, 1); qv += __shfl_xor(qv, 2); qv += __shfl_xor(qv, 4);
            const float rstd = 1.f / sqrtf(qv * (1.f / 64.f) + LN_EPS);
            float g8[8], o[8]; unpack8(cg_, g8);
#pragma unroll
            for (int e = 0; e < 8; ++e) { const float yv = x[e] * rstd * lnw[8 * kg + e] + lnb[8 * kg + e]; o[e] = yv * g8[e] * sigmoidf_(g8[e]); }
            *(v4u*)(act + (tb + t) * D + hh * 64 + 8 * kg) = pack8(o);
        }
    }
}
template <int CTRL> DI float dppx(float x) { return __builtin_bit_cast(float, __builtin_amdgcn_update_dpp(0, __builtin_bit_cast(int, x), CTRL, 0xF, 0xF, true)); }
DI void rwkv_scan2_item(KA a, LAS unsigned char* lds, const int item) {
    const int tid = tid_(), lane = tid & 63, w = tid >> 6, kl = lane & 15, row0 = w * 8 + 2 * (lane >> 4);
    const int half = item & 1, bh = item >> 1, hd = bh & 3, b = bh >> 2;
    unsigned char* ws = a->ws;
    const float* Rw = (const float*)(ws + WS_RW); const bf16* Rr = (const bf16*)(ws + WS_RR); const bf16* Rk = (const bf16*)(ws + WS_RK); const bf16* Rv = (const bf16*)(ws + WS_RV); const bf16* Ra = (const bf16*)(ws + WS_RA); const bf16* Rb = (const bf16*)(ws + WS_RB);
    bf16* H = (bf16*)(ws + WS_H);
    LAS float* sb = (LAS float*)lds; LAS float* yb = sb + 2 * SBUF_F;
    const int stk = tid >> 4, spart = tid & 15;
    const size_t gbase = (size_t)b * SEQ * 256 + hd * 64;
    f32x4 gw; v2u gr, gk, ga, gb; unsigned gv;
#define RW_LOAD(c) do { const size_t o_ = gbase + (size_t)((c) * SC + stk) * 256 + 4 * spart; gw = *(const f32x4*)(Rw + o_); gr = *(const v2u*)(Rr + o_); gk = *(const v2u*)(Rk + o_); ga = *(const v2u*)(Ra + o_); gb = *(const v2u*)(Rb + o_); \
        gv = *(const unsigned*)(Rv + gbase + (size_t)((c) * SC + stk) * 256 + half * 32 + 2 * spart); } while (0)
#define BF4(u_) ((f32x4){bflo((u_).x), bfhi((u_).x), bflo((u_).y), bfhi((u_).y)})
#define RW_STORE(bufi) do { LAS float* d_ = sb + (bufi) * SBUF_F; const int o_ = stk * 64 + 4 * spart; \
        *(LAS f32x4*)(d_ + o_) = BF4(gr); *(LAS f32x4*)(d_ + SC * 64 + o_) = gw; *(LAS f32x4*)(d_ + 2 * SC * 64 + o_) = BF4(gk); *(LAS f32x4*)(d_ + 3 * SC * 64 + o_) = BF4(ga); \
        *(LAS f32x4*)(d_ + 4 * SC * 64 + o_) = BF4(gb); *(LAS f32x2*)(d_ + 5 * SC * 64 + stk * 32 + 2 * spart) = (f32x2){bflo(gv), bfhi(gv)}; } while (0)
#define FLUSH(c_) do { const LAS float* ys = yb + ((c_) & 1) * SC * 32 + (2 * spart) * SC + stk; \
        *(unsigned*)(H + ((size_t)b * SEQ + (size_t)(c_) * SC + stk) * HP + C_RR + hd * 64 + half * 32 + 2 * spart) = pk2(ys[0], ys[SC]); } while (0)
    __syncthreads();
    RW_LOAD(0); RW_STORE(0);
    __syncthreads();
    f32x2 s00 = {0.f, 0.f}, s01 = {0.f, 0.f}, s10 = {0.f, 0.f}, s11 = {0.f, 0.f};
    constexpr int NCH = SEQ / SC;
    for (int c = 0; c < NCH; ++c) {
        if (c + 1 < NCH) RW_LOAD(c + 1);
        if (c > 0) FLUSH(c - 1);
        if (w < 4) {
            const LAS float* d_ = sb + (c & 1) * SBUF_F; LAS float* yo = yb + (c & 1) * SC * 32;
            for (int t4 = 0; t4 < SC; t4 += 4) {
                f32x4 R4[4], W4[4], K4[4], A4[4], B4[4]; f32x2 V2[4]; float y0[4], y1[4];
#pragma unroll
                for (int u = 0; u < 4; ++u) { const int o_ = (t4 + u) * 64 + 4 * kl;
                    R4[u] = *(const LAS f32x4*)(d_ + o_); W4[u] = *(const LAS f32x4*)(d_ + SC * 64 + o_); K4[u] = *(const LAS f32x4*)(d_ + 2 * SC * 64 + o_);
                    A4[u] = *(const LAS f32x4*)(d_ + 3 * SC * 64 + o_); B4[u] = *(const LAS f32x4*)(d_ + 4 * SC * 64 + o_); V2[u] = *(const LAS f32x2*)(d_ + 5 * SC * 64 + (t4 + u) * 32 + row0); }
#pragma unroll
                for (int u = 0; u < 4; ++u) {
                    const f32x2 a01 = {A4[u][0], A4[u][1]}, a23 = {A4[u][2], A4[u][3]}, b01 = {B4[u][0], B4[u][1]}, b23 = {B4[u][2], B4[u][3]};
                    const f32x2 k01 = {K4[u][0], K4[u][1]}, k23 = {K4[u][2], K4[u][3]}, w01 = {W4[u][0], W4[u][1]}, w23 = {W4[u][2], W4[u][3]}, r01 = {R4[u][0], R4[u][1]}, r23 = {R4[u][2], R4[u][3]};
                    f32x2 p0 = s00 * a01; p0 = s01 * a23 + p0; f32x2 p1 = s10 * a01; p1 = s11 * a23 + p1;
                    float d0 = p0[0] + p0[1], d1 = p1[0] + p1[1];
                    d0 = ror_add<0x128>(d0); d1 = ror_add<0x128>(d1); d0 = ror_add<0x124>(d0); d1 = ror_add<0x124>(d1); d0 = ror_add<0x122>(d0); d1 = ror_add<0x122>(d1); d0 = ror_add<0x121>(d0); d1 = ror_add<0x121>(d1);
                    const float v0 = V2[u][0], v1 = V2[u][1];
                    s00 = s00 * w01 + (k01 * v0 + b01 * d0); s01 = s01 * w23 + (k23 * v0 + b23 * d0);
                    s10 = s10 * w01 + (k01 * v1 + b01 * d1); s11 = s11 * w23 + (k23 * v1 + b23 * d1);
                    f32x2 q0 = s00 * r01; q0 = s01 * r23 + q0; f32x2 q1 = s10 * r01; q1 = s11 * r23 + q1;
                    y0[u] = q0[0] + q0[1]; y1[u] = q1[0] + q1[1];
                }
                {
                    const bool b3 = (kl & 8) != 0, b2 = (kl & 4) != 0, b1 = (kl & 2) != 0;
                    float w4[4], x2[2];
#pragma unroll
                    for (int u = 0; u < 4; ++u) { const float keep = b3 ? y1[u] : y0[u], send = b3 ? y0[u] : y1[u]; w4[u] = keep + dppx<0x140>(send); }
#pragma unroll
                    for (int u = 0; u < 2; ++u) { const float keep = b2 ? w4[2 + u] : w4[u], send = b2 ? w4[u] : w4[2 + u]; x2[u] = keep + dppx<0x141>(send); }
                    const float keep1 = b1 ? x2[1] : x2[0], send1 = b1 ? x2[0] : x2[1];
                    float z = keep1 + dppx<0x1B>(send1);
                    z = z + dppx<0xB1>(z);
                    if ((kl & 1) == 0) yo[(row0 + (b3 ? 1 : 0)) * SC + t4 + (b2 ? 2 : 0) + (b1 ? 1 : 0)] = z;
                }
            }
        }
        if (c + 1 < NCH) RW_STORE((c + 1) & 1);
        __syncthreads();
    }
    FLUSH(NCH - 1);
#undef RW_LOAD
#undef RW_STORE
#undef BF4
#undef FLUSH
}
constexpr float QSCALE = 0.125f * 1.4426950408889634f;
DI void nsa_rope(KA a) {
    const int tid = tid_();
    unsigned char* ws = a->ws; bf16* H = (bf16*)(ws + WS_H); const float* ct = (const float*)(ws + WS_COS); const float* st = (const float*)(ws + WS_SIN);
    const int ustride = gridDim.x * NTHR;
    for (int u0 = blockIdx.x * NTHR + tid; u0 < T * 48; u0 += 2 * ustride) {
        v4u a1[2], a2[2]; f32x4 cc[2][2], sn[2][2]; bf16* pp[2]; float scs[2]; bool ok[2];
#pragma unroll
        for (int q = 0; q < 2; ++q) { const int u = u0 + q * ustride; ok[q] = u < T * 48; if (ok[q]) { const int t = u / 48, rem = u - t * 48, hd = rem >> 2, m = rem & 3, pos = t & (SEQ - 1);
            const int col0 = hd < 8 ? C_NQ + hd * 64 : (hd < 10 ? C_NKS + (hd - 8) * 64 : C_NKW + (hd - 10) * 64); scs[q] = hd < 8 ? QSCALE : 1.f;
            pp[q] = H + (size_t)t * HP + col0 + 8 * m; a1[q] = *(const v4u*)pp[q]; a2[q] = *(const v4u*)(pp[q] + 32);
            cc[q][0] = *(const f32x4*)(ct + pos * 32 + 8 * m); cc[q][1] = *(const f32x4*)(ct + pos * 32 + 8 * m + 4); sn[q][0] = *(const f32x4*)(st + pos * 32 + 8 * m); sn[q][1] = *(const f32x4*)(st + pos * 32 + 8 * m + 4); } }
#pragma unroll
        for (int q = 0; q < 2; ++q) if (ok[q]) { float x1[8], x2[8], o1[8], o2[8]; unpack8(a1[q], x1); unpack8(a2[q], x2);
#pragma unroll
            for (int e = 0; e < 8; ++e) { const float c = cc[q][e >> 2][e & 3], s = sn[q][e >> 2][e & 3]; o1[e] = (x1[e] * c - x2[e] * s) * scs[q]; o2[e] = (x1[e] * s + x2[e] * c) * scs[q]; }
            *(v4u*)pp[q] = pack8(o1); *(v4u*)(pp[q] + 32) = pack8(o2); }
    }
}
constexpr int PH = 264;
DI float gelu_tanh(float x) { return 0.5f * x * (1.f + fast_tanh(0.7978845608028654f * (x + 0.044715f * x * x * x))); }
DI void nsa_compress_item(KA a, const int l, LAS unsigned char* lds, const int it) {
    const int tid = tid_(), lane = tid & 63, w = tid >> 6, fr = lane & 15, fq = lane >> 4;
    const int kv = it & 1, ctile = (it >> 1) & 1, bg = it >> 2, b = bg >> 1, g = bg & 1;
    unsigned char* ws = a->ws; const bf16* H = (const bf16*)(ws + WS_H); const float* ctab = (const float*)(ws + WS_COS); const float* stab = (const float*)(ws + WS_SIN);
    LAS bf16* At = (LAS bf16*)lds; LAS bf16* Hd = At + 64 * PA;
    const bf16* W1T = (const bf16*)(ws + WS_WC1 + (size_t)(l * 2 + kv) * MiB);
    const bf16* W2T = (const bf16*)(ws + WS_SMALL + l * SMALL_STRIDE + (kv ? SM_WV2T : SM_WK2T));
    const float* pos = a->in[kv ? I_POSV : I_POSK] + l * 32 * 64;
    const int colbase = (kv ? C_NVC : C_NKC) + g * 64;
    f32x4 acc[4][2];
#pragma unroll
    for (int rt = 0; rt < 4; ++rt) { acc[rt][0] = ZERO4; acc[rt][1] = ZERO4; }
    const bool stager = (tid & 7) < 4; const int sc_ = tid >> 3, sm_ = tid & 3, scg = 64 * ctile + sc_; const bool svalid = scg < 127;
    v4u xr1 = {0u, 0u, 0u, 0u}, xr2 = {0u, 0u, 0u, 0u}; f32x4 cs[2], sn[2], ps1[2], ps2[2]; bf16x8 bcur[2][2], bnxt[2][2];
#define CMP_LOADA(ll_) do { if (stager) { const int s_ = 16 * scg + (ll_); if (svalid) { const bf16* hp_ = H + ((size_t)b * SEQ + s_) * HP + colbase + 8 * sm_; xr1 = *(const v4u*)hp_; xr2 = *(const v4u*)(hp_ + 32); \
            if (kv == 0) { cs[0] = *(const f32x4*)(ctab + s_ * 32 + 8 * sm_); cs[1] = *(const f32x4*)(ctab + s_ * 32 + 8 * sm_ + 4); sn[0] = *(const f32x4*)(stab + s_ * 32 + 8 * sm_); sn[1] = *(const f32x4*)(stab + s_ * 32 + 8 * sm_ + 4); } } \
            ps1[0] = *(const f32x4*)(pos + (ll_) * 64 + 8 * sm_); ps1[1] = *(const f32x4*)(pos + (ll_) * 64 + 8 * sm_ + 4); ps2[0] = *(const f32x4*)(pos + (ll_) * 64 + 32 + 8 * sm_); ps2[1] = *(const f32x4*)(pos + (ll_) * 64 + 32 + 8 * sm_ + 4); } } while (0)
#define CMP_LOADB(dst, ll_) do { _Pragma("unroll") for (int ks = 0; ks < 2; ++ks) _Pragma("unroll") for (int ct = 0; ct < 2; ++ct) dst[ks][ct] = *(const bf16x8*)(W1T + (size_t)(32 * w + 16 * ct + fr) * 2048 + (ll_) * 64 + ks * 32 + fq * 8); } while (0)
    CMP_LOADA(0); CMP_LOADB(bcur, 0);
    for (int ll = 0; ll < 32; ++ll) {
        __syncthreads();
        if (stager) { float x1[8], x2[8], o1[8], o2[8]; unpack8(xr1, x1); unpack8(xr2, x2);
#pragma unroll
            for (int e = 0; e < 8; ++e) { float y1 = svalid ? x1[e] : 0.f, y2 = svalid ? x2[e] : 0.f;
                if (kv == 0 && svalid) { const float cc = cs[e >> 2][e & 3], ss = sn[e >> 2][e & 3]; y1 = x1[e] * cc - x2[e] * ss; y2 = x1[e] * ss + x2[e] * cc; }
                o1[e] = y1 + ps1[e >> 2][e & 3]; o2[e] = y2 + ps2[e >> 2][e & 3]; }
            *(LAS v4u*)(At + sc_ * PA + 8 * sm_) = pack8(o1); *(LAS v4u*)(At + sc_ * PA + 32 + 8 * sm_) = pack8(o2); }
        __syncthreads();
        if (ll + 1 < 32) { CMP_LOADA(ll + 1); CMP_LOADB(bnxt, ll + 1); }
#pragma unroll
        for (int ks = 0; ks < 2; ++ks) {
#pragma unroll
            for (int rt = 0; rt < 4; ++rt) { const bf16x8 af = *(const LAS bf16x8*)(At + (16 * rt + fr) * PA + ks * 32 + fq * 8); acc[rt][0] = mma16(af, bcur[ks][0], acc[rt][0]); acc[rt][1] = mma16(af, bcur[ks][1], acc[rt][1]); } }
#pragma unroll
        for (int ks = 0; ks < 2; ++ks) { bcur[ks][0] = bnxt[ks][0]; bcur[ks][1] = bnxt[ks][1]; }
    }
#undef CMP_LOADA
#undef CMP_LOADB
    __syncthreads();
#pragma unroll
    for (int rt = 0; rt < 4; ++rt)
#pragma unroll
        for (int ct = 0; ct < 2; ++ct)
#pragma unroll
            for (int j = 0; j < 4; ++j) Hd[(16 * rt + 4 * fq + j) * PH + 32 * w + 16 * ct + fr] = (bf16)f2bf(gelu_tanh(acc[rt][ct][j]));
    __syncthreads();
    const int rt2 = w & 3, ct2 = (w >> 2) * 2;
    f32x4 o2[2] = {ZERO4, ZERO4};
#pragma unroll
    for (int ks = 0; ks < 8; ++ks) { const bf16x8 af = *(const LAS bf16x8*)(Hd + (16 * rt2 + fr) * PH + ks * 32 + fq * 8);
#pragma unroll
        for (int i = 0; i < 2; ++i) { const bf16x8 bfr = *(const bf16x8*)(W2T + (size_t)(16 * (ct2 + i) + fr) * 256 + ks * 32 + fq * 8); o2[i] = mma16(af, bfr, o2[i]); } }
    bf16* dst = (bf16*)(ws + (kv ? WS_VCMP : WS_KCMP)) + (size_t)bg * 128 * 64;
#pragma unroll
    for (int i = 0; i < 2; ++i)
#pragma unroll
        for (int j = 0; j < 4; ++j) { const int cg = 64 * ctile + 16 * rt2 + 4 * fq + j; dst[cg * 64 + 16 * (ct2 + i) + fr] = (bf16)f2bf(cg < 127 ? o2[i][j] : 0.f); }
}


constexpr int PV = 136;
constexpr int NSA_KT = 0, NSA_VT = 18432, NSA_KT1 = 36864, NSA_VT1 = 46080, NSA_IMP = 65536, NSA_IMPT = 98304, NSA_SELM = 106496, NSA_LIST = 106752, NSA_NLIST = 106944, NSA_UN = 106960, NSA_ITEM = 107008;
DI int crow(int i, int hf) { return (i & 3) + 8 * (i >> 2) + 4 * hf; }
DI bf16x8 packp(const f32x16& x, const int h8) { v4u p; p.x = pk2(x[h8 + 0], x[h8 + 1]); p.y = pk2(x[h8 + 2], x[h8 + 3]); p.z = pk2(x[h8 + 4], x[h8 + 5]); p.w = pk2(x[h8 + 6], x[h8 + 7]); return __builtin_bit_cast(bf16x8, p); }
DI int vpos(const int key) { return (key & ~15) + (((key >> 3) & 1) << 2) + (((key >> 2) & 1) << 3) + (key & 3); }
DI bf16x8 vfrag(const LAS bf16* VT, const int row, const int sp, const int hf) { return *(const LAS bf16x8*)(VT + row * PV + 16 * sp + 8 * hf); }
#define ZERO16 ((f32x16){0.f,0.f,0.f,0.f,0.f,0.f,0.f,0.f,0.f,0.f,0.f,0.f,0.f,0.f,0.f,0.f})
DI void nsa_item(KA a, LAS unsigned char* lds, const int it) {
    const int tid = tid_(), lane = tid & 63, w = tid >> 6, r = lane & 31, hf = lane >> 5;
    const int qb = 31 - (it >> 5), bg = it & 31, b = bg >> 1, g = bg & 1, hh = w >> 1, head = g * 4 + hh, tql = 32 * (w & 1) + r;
    unsigned char* ws = a->ws; const bf16* H = (const bf16*)(ws + WS_H); bf16* act = (bf16*)(ws + WS_ACT);
    const size_t tokrow = (size_t)b * SEQ + 64 * qb + tql;
    LAS bf16* Kt = (LAS bf16*)(lds + NSA_KT); LAS bf16* VT = (LAS bf16*)(lds + NSA_VT); LAS float* IMP = (LAS float*)(lds + NSA_IMP); LAS float* IMPT = (LAS float*)(lds + NSA_IMPT);
    LAS unsigned* SELM = (LAS unsigned*)(lds + NSA_SELM); LAS int* LIST = (LAS int*)(lds + NSA_LIST); LAS int* NLIST = (LAS int*)(lds + NSA_NLIST);
    bf16x8 bq[4];
#pragma unroll
    for (int s = 0; s < 4; ++s) bq[s] = *(const bf16x8*)(H + tokrow * HP + C_NQ + head * 64 + 16 * s + 8 * hf);
    const float g0 = sigmoidf_(ldbf(H + tokrow * HP + C_NG + head * 3 + 0)), g1 = sigmoidf_(ldbf(H + tokrow * HP + C_NG + head * 3 + 1)), g2 = sigmoidf_(ldbf(H + tokrow * HP + C_NG + head * 3 + 2));
    { const bf16* kc = (const bf16*)(ws + WS_KCMP) + (size_t)bg * 128 * 64; const bf16* vc = (const bf16*)(ws + WS_VCMP) + (size_t)bg * 128 * 64;
#pragma unroll
      for (int i = 0; i < 2; ++i) { const int idx = tid + NTHR * i; const int c = idx >> 3, ch = idx & 7; *(LAS v4u*)(Kt + c * PA + 8 * ch) = *(const v4u*)(kc + c * 64 + 8 * ch);
          const int dg = idx & 15, kp = idx >> 4; const v2u v0 = *(const v2u*)(vc + (2 * kp) * 64 + 4 * dg), v1 = *(const v2u*)(vc + (2 * kp + 1) * 64 + 4 * dg);
          LAS unsigned* d0 = (LAS unsigned*)(VT + (4 * dg) * PV + vpos(2 * kp));
          d0[0] = (v0.x & 0xffffu) | (v1.x << 16); d0[PV / 2] = (v0.x >> 16) | (v1.x & 0xffff0000u); d0[PV] = (v0.y & 0xffffu) | (v1.y << 16); d0[3 * PV / 2] = (v0.y >> 16) | (v1.y & 0xffff0000u); } }
    __syncthreads();
    f32x16 of[2] = {ZERO16, ZERO16};
    {
        f32x16 st[4] = {ZERO16, ZERO16, ZERO16, ZERO16};
#pragma unroll
        for (int k4 = 0; k4 < 4; ++k4)
#pragma unroll
            for (int s = 0; s < 4; ++s) { const bf16x8 af = *(const LAS bf16x8*)(Kt + (32 * k4 + r) * PA + 16 * s + 8 * hf); st[k4] = mma32(af, bq[s], st[k4]); }
        const int tq = 64 * qb + tql; float mx = -INFINITY;
#pragma unroll
        for (int k4 = 0; k4 < 4; ++k4)
#pragma unroll
            for (int i = 0; i < 16; ++i) { const int c = 32 * k4 + crow(i, hf); const bool ok = (16 * c + 31 <= tq); st[k4][i] = ok ? st[k4][i] : -INFINITY; mx = fmaxf(mx, st[k4][i]); }
        mx = fmaxf(mx, __shfl_xor(mx, 32)); const float mref = (mx == -INFINITY) ? 0.f : mx; float ls = 0.f;
#pragma unroll
        for (int k4 = 0; k4 < 4; ++k4)
#pragma unroll
            for (int i = 0; i < 16; ++i) { const float p = __builtin_amdgcn_exp2f(st[k4][i] - mref); st[k4][i] = p; ls += p; }
        ls += __shfl_xor(ls, 32); const float inv = ls > 0.f ? 1.f / ls : 0.f;
#pragma unroll
        for (int k4 = 0; k4 < 4; ++k4) st[k4] = st[k4] * inv;
        f32x16 ot[2] = {ZERO16, ZERO16};
#pragma unroll
        for (int sp = 0; sp < 8; ++sp) { const bf16x8 pf = packp(st[sp >> 1], 8 * (sp & 1));
#pragma unroll
            for (int dh = 0; dh < 2; ++dh) ot[dh] = mma32(vfrag(VT, 32 * dh + r, sp, hf), pf, ot[dh]); }
        of[0] = ot[0] * g0; of[1] = ot[1] * g0;
        if (qb >= 16) {
        float A16[16], B16[16];
#pragma unroll
        for (int k4 = 0; k4 < 4; ++k4)
#pragma unroll
            for (int q4 = 0; q4 < 4; ++q4) { const float p0 = st[k4][4 * q4], p1 = st[k4][4 * q4 + 1], p2 = st[k4][4 * q4 + 2], p3 = st[k4][4 * q4 + 3]; A16[4 * k4 + q4] = 2.f * (p0 + p1 + p2) + p3; B16[4 * k4 + q4] = p3; }
        float rc[16];
#pragma unroll
        for (int gq = 0; gq < 16; ++gq) rc[gq] = __shfl_xor(B16[gq], 32);
#pragma unroll
        for (int gq = 0; gq < 16; ++gq) { const float prevb = hf ? rc[gq] : (gq > 0 ? rc[gq > 0 ? gq - 1 : 0] : 0.f); IMP[(hh * 64 + tql) * 32 + 2 * gq + hf] = A16[gq] + prevb; }
        }
    }
    if (qb >= 16) {
    __syncthreads();
    { const int tok = tid >> 3, j0 = 4 * (tid & 7);
#pragma unroll
      for (int e = 0; e < 4; ++e) IMPT[tok * 32 + j0 + e] = (IMP[(0 * 64 + tok) * 32 + j0 + e] + IMP[(1 * 64 + tok) * 32 + j0 + e]) + (IMP[(2 * 64 + tok) * 32 + j0 + e] + IMP[(3 * 64 + tok) * 32 + j0 + e]); }
    }
    __syncthreads();
    { const int tok = tid >> 3, j0 = 4 * (tid & 7); unsigned bits = 0u;
      if (qb < 16) bits = (1u << (qb + 1)) - 1u;
      else { float iv[32];
#pragma unroll
          for (int q = 0; q < 8; ++q) { const f32x4 t4 = *(const LAS f32x4*)(IMPT + tok * 32 + 4 * q); iv[4 * q] = t4[0]; iv[4 * q + 1] = t4[1]; iv[4 * q + 2] = t4[2]; iv[4 * q + 3] = t4[3]; }
#pragma unroll
          for (int e = 0; e < 4; ++e) { const int j = j0 + e; const float v = IMPT[tok * 32 + j]; int rank = 0;
#pragma unroll
              for (int jp = 1; jp < 32; ++jp) rank += (jp <= qb - 2 && (iv[jp] > v || (iv[jp] == v && jp < j))) ? 1 : 0;
              if (j >= 1 && j <= qb - 2 && rank < 13) bits |= 1u << j; }
          bits |= __shfl_xor(bits, 1); bits |= __shfl_xor(bits, 2); bits |= __shfl_xor(bits, 4);
          bits |= 1u | (1u << qb) | (1u << (qb - 1)); }
      if ((tid & 7) == 0) SELM[tok] = bits;
      unsigned un = bits; un |= __shfl_xor(un, 8); un |= __shfl_xor(un, 16); un |= __shfl_xor(un, 32);
      if (lane == 0) ((LAS unsigned*)(lds + NSA_UN))[w] = un; }
    __syncthreads();
    {
        unsigned un = 0u;
#pragma unroll
        for (int i = 0; i < 8; ++i) un |= ((LAS unsigned*)(lds + NSA_UN))[i];
        const int nslc = __popc(un), w0 = qb > 8 ? qb - 8 : 0, nwin = qb - w0 + 1;
        if (tid < 32) { if ((un >> tid) & 1u) LIST[__popc(un & ((1u << tid) - 1u))] = tid; }
        else if (tid < 32 + nwin) LIST[nslc + (tid - 32)] = 256 + w0 + (tid - 32);
        if (tid == 0) *NLIST = nslc + nwin; }
    __syncthreads();
    const unsigned mysel = SELM[tql]; const int n = *NLIST;
    v4u kreg; v2u vr0, vr1;
    const int skey = tid >> 3, sch = tid & 7, sdg = tid & 15, skp = tid >> 4;
#define NSA_LOAD(desc) do { const int ty_ = (desc) >> 8, j_ = (desc) & 255; const size_t row_ = (size_t)b * SEQ + 64 * j_; const int kc_ = (ty_ ? C_NKW : C_NKS) + g * 64, vc_ = (ty_ ? C_NVW : C_NVS) + g * 64; \
        kreg = *(const v4u*)(H + (row_ + skey) * HP + kc_ + 8 * sch); vr0 = *(const v2u*)(H + (row_ + 2 * skp) * HP + vc_ + 4 * sdg); vr1 = *(const v2u*)(H + (row_ + 2 * skp + 1) * HP + vc_ + 4 * sdg); } while (0)
#define NSA_STORE(Kb, Vb) do { *(LAS v4u*)((Kb) + skey * PA + 8 * sch) = kreg; LAS unsigned* d0_ = (LAS unsigned*)((Vb) + (4 * sdg) * PV + vpos(2 * skp)); \
        d0_[0] = (vr0.x & 0xffffu) | (vr1.x << 16); d0_[PV / 2] = (vr0.x >> 16) | (vr1.x & 0xffff0000u); d0_[PV] = (vr0.y & 0xffffu) | (vr1.y << 16); d0_[3 * PV / 2] = (vr0.y >> 16) | (vr1.y & 0xffff0000u); } while (0)
    LAS bf16* Kt1 = (LAS bf16*)(lds + NSA_KT1); LAS bf16* VT1 = (LAS bf16*)(lds + NSA_VT1);
    NSA_LOAD(LIST[0]); NSA_STORE(Kt, VT);
    NSA_LOAD(LIST[1]);
    __syncthreads();
    float m_ref = 0.f, l_run = 0.f; f32x16 ot[2] = {ZERO16, ZERO16}; int curtype = 0;
    for (int i = 0; i < n; ++i) {
        const int desc = LIST[i]; const int ty = desc >> 8, j = desc & 255;
        const LAS bf16* Kc = (i & 1) ? Kt1 : Kt; const LAS bf16* Vc = (i & 1) ? VT1 : VT;
        if (ty != curtype) { const float lt = l_run + __shfl_xor(l_run, 32); const float sc = g1 / lt; of[0] += ot[0] * sc; of[1] += ot[1] * sc; ot[0] = ZERO16; ot[1] = ZERO16; m_ref = 0.f; l_run = 0.f; curtype = ty; }
        const bool rowoff = (ty == 0) && (((mysel >> j) & 1u) == 0u);
        const int mode = (j == qb) ? 1 : ((ty == 1 && j == qb - 8) ? 2 : 0);
        const float init = rowoff ? -INFINITY : -m_ref;
        f32x16 st[2];
#pragma unroll
        for (int i2 = 0; i2 < 16; ++i2) { st[0][i2] = init; st[1][i2] = init; }
#pragma unroll
        for (int kt = 0; kt < 2; ++kt)
#pragma unroll
            for (int s = 0; s < 4; ++s) { const bf16x8 af = *(const LAS bf16x8*)(Kc + (32 * kt + r) * PA + 16 * s + 8 * hf); st[kt] = mma32(af, bq[s], st[kt]); }
        if (mode != 0) {
#pragma unroll
            for (int kt = 0; kt < 2; ++kt)
#pragma unroll
                for (int i2 = 0; i2 < 16; ++i2) { const int kl = 32 * kt + crow(i2, hf); const bool bad = rowoff || (mode == 1 && kl > tql) || (mode == 2 && kl <= tql); st[kt][i2] = bad ? -INFINITY : st[kt][i2]; }
        }
        float mx = -INFINITY;
#pragma unroll
        for (int kt = 0; kt < 2; ++kt)
#pragma unroll
            for (int i2 = 0; i2 < 16; ++i2) mx = fmaxf(mx, st[kt][i2]);
        mx = fmaxf(mx, __shfl_xor(mx, 32));
        const bool drift = (fabsf(mx) > 24.f) && (mx > -INFINITY);
        if (__any(drift)) {
            const float d = drift ? mx : 0.f, scl = __builtin_amdgcn_exp2f(-d); m_ref += d; l_run *= scl; ot[0] = ot[0] * scl; ot[1] = ot[1] * scl;
#pragma unroll
            for (int kt = 0; kt < 2; ++kt)
#pragma unroll
                for (int i2 = 0; i2 < 16; ++i2) st[kt][i2] -= d;
        }
        f32x2 ls2 = {0.f, 0.f};
#pragma unroll
        for (int kt = 0; kt < 2; ++kt)
#pragma unroll
            for (int i2 = 0; i2 < 16; i2 += 2) { const float p0 = __builtin_amdgcn_exp2f(st[kt][i2]), p1 = __builtin_amdgcn_exp2f(st[kt][i2 + 1]); st[kt][i2] = p0; st[kt][i2 + 1] = p1; ls2 += (f32x2){p0, p1}; }
        l_run += ls2[0] + ls2[1];
#pragma unroll
        for (int sp = 0; sp < 4; ++sp) { const bf16x8 pf = packp(st[sp >> 1], 8 * (sp & 1));
#pragma unroll
            for (int dh = 0; dh < 2; ++dh) ot[dh] = mma32(vfrag(Vc, 32 * dh + r, sp, hf), pf, ot[dh]); }
        if (i + 1 < n) { if (i & 1) NSA_STORE(Kt, VT); else NSA_STORE(Kt1, VT1); if (i + 2 < n) NSA_LOAD(LIST[i + 2]); }
        __syncthreads();
    }
    { const float lt = l_run + __shfl_xor(l_run, 32); const float sc = g2 / lt; of[0] += ot[0] * sc; of[1] += ot[1] * sc; }
#undef NSA_LOAD
#undef NSA_STORE
#pragma unroll
    for (int dh = 0; dh < 2; ++dh)
#pragma unroll
        for (int q4 = 0; q4 < 4; ++q4) { v2u p; p.x = pk2(of[dh][4 * q4], of[dh][4 * q4 + 1]); p.y = pk2(of[dh][4 * q4 + 2], of[dh][4 * q4 + 3]);
            *(v2u*)(act + tokrow * D + 512 + head * 64 + 32 * dh + 8 * q4 + 4 * hf) = p; }
}
DI void nsa_main(KA a, const int l, LAS unsigned char* lds, const int rep = 0) {
    unsigned* ctr = (unsigned*)(a->ws + WS_CTL) + 64 * (l + 2 * rep);
    for (;;) {
        __syncthreads();
        if (tid_() == 0) *(LAS int*)(lds + NSA_ITEM) = (int)atomicAdd(ctr, 1u);
        __syncthreads();
        const int it = *(LAS int*)(lds + NSA_ITEM);
        if (it >= 1024) break;
        nsa_item(a, lds, it);
    }
}
#ifndef REP_MAIN
#define REP_MAIN 1
#endif
#ifndef REP_PREP
#define REP_PREP 1
#endif
#ifndef EN_PREP
#define EN_PREP 1
#endif
#ifndef EN_GLA
#define EN_GLA 1
#endif
#ifndef EN_SCAN
#define EN_SCAN 1
#endif
#ifndef EN_POST
#define EN_POST 1
#endif
DI void prep_phase(KA a, const int l, LAS unsigned char* lds) {
    nsa_rope(a);
    for (int rep = 0; rep < REP_PREP; ++rep) {
        unsigned* ctr = (unsigned*)(a->ws + WS_CTL) + 64 * (4 + l + 2 * rep);
        for (;;) {
            __syncthreads();
            if (tid_() == 0) *(LAS int*)(lds + NSA_ITEM) = (int)atomicAdd(ctr, 1u);
            __syncthreads();
            const int it = *(LAS int*)(lds + NSA_ITEM);
            if (it >= 128 + T / 64) break;
            if (it < 128) nsa_compress_item(a, l, lds, it); else rwkv_prep_item(a, l, lds, it - 128);
        }
    }
}
DI void main_phase(KA a, const int l, LAS unsigned char* lds) {
    const int bx = blockIdx.x;
    for (int rep = 0; rep < REP_MAIN; ++rep) {
#if EN_GLA
    if (bx < 64) gla_item(a, l, lds, bx);
#ifdef REP_GLA
    if (bx < 64) gla_item(a, l, lds, bx);
#endif
#endif
#if EN_SCAN
    if (bx >= 64 && bx < 192) rwkv_scan2_item(a, lds, bx - 64);
#ifdef REP_SCAN
    if (bx >= 64 && bx < 192) rwkv_scan2_item(a, lds, bx - 64);
#endif
#endif
    nsa_main(a, l, lds, rep);
    }
}
DI void post_phase(KA a, const int l, LAS unsigned char* lds) {
#if EN_POST
    for (int rep = 0; rep < REP_PREP; ++rep)
    for (int tile = blockIdx.x; tile < T / 64; tile += gridDim.x) rwkv_post_item(a, l, lds, tile);
#endif
}

DI void main_phase_a(KA a, const int l, LAS unsigned char* lds) {
    const int bx = blockIdx.x;
    if (bx < 64) gla_item(a, l, lds, bx);
    if (bx >= 64 && bx < 192) rwkv_scan2_item(a, lds, bx - 64);
}
DI void main_phase_b(KA a, const int l, LAS unsigned char* lds) { nsa_main(a, l, lds, 0); }
__global__ void __launch_bounds__(NTHR, 2) fwd_megakernel(Args a_unused) {
    extern __shared__ __attribute__((aligned(16))) unsigned char lds_raw[];
    LAS unsigned char* lds = (LAS unsigned char*)lds_raw;
    cg::grid_group grid = cg::this_grid();
    { LAS unsigned* z = (LAS unsigned*)(lds + XB_LDS_OFF); if (tid_() < 4) z[tid_()] = 0u; }
    __syncthreads();
    if (blockIdx.x == 0) { unsigned* ctl = (unsigned*)(ARGS()->ws + WS_CTL); for (int i = tid_(); i < (int)(CTL_BYTES / 4); i += NTHR) ctl[i] = 0u; }
    { KA a = ARGS(); prologue(a, lds); }
#ifdef REP_PRO
    __syncthreads();
    { KA a = ARGS(); prologue(a, lds); }
#endif
    grid.sync();
    const XcdBarrier xbar = xcd_barrier_post((unsigned*)(ARGS()->ws + WS_CTL) + CW_BAR, (volatile LAS unsigned*)(lds + XB_LDS_OFF));
#ifdef EXTRA_SYNCS
    for (int i = 0; i < EXTRA_SYNCS; ++i) xcd_barrier(xbar);
#endif
#pragma unroll
    for (int l = 0; l < 2; ++l) {
        { KA a = ARGS(); unsigned char* ws = a->ws;
          pg8::Gemm g{(const bf16*)(ws + WS_ACT), (const bf16*)(ws + WS_WIN + l * WIN_STRIDE), T, HP, D}; pg8::StaticOrder S; S.init(T, HP, gridDim.x, blockIdx.x, WGM_IN);
          EpiH E{(bf16*)(ws + WS_H), HP}; pg8::gemm_phase<EpiH, pg8::StaticOrder, true, true>(lds, g, S, E);
#ifdef REP_GEMM
          pg8::gemm_phase<EpiH, pg8::StaticOrder, true, true>(lds, g, S, E);
#endif
        }
        xcd_barrier(xbar);
        { KA a = ARGS(); prep_phase(a, l, lds); }
        xcd_barrier(xbar);
#ifdef SPLIT_MAIN
        { KA a = ARGS(); main_phase_a(a, l, lds); }
        xcd_barrier(xbar);
        { KA a = ARGS(); main_phase_b(a, l, lds); }
#else
        { KA a = ARGS(); main_phase(a, l, lds); }
#endif
        xcd_barrier(xbar);
        { KA a = ARGS(); post_phase(a, l, lds); }
        xcd_barrier(xbar);
        { KA a = ARGS(); unsigned char* ws = a->ws;
          pg8::Gemm g{(const bf16*)(ws + WS_ACT), (const bf16*)(ws + WS_WOUT + l * WOUT_STRIDE), T, D, D}; pg8::StaticOrder S; S.init(T, D, gridDim.x, blockIdx.x, WGM_N1K);
          EpiRes E{l == 0 ? a->in[I_X] : a->out, a->out}; pg8::gemm_phase<EpiRes, pg8::StaticOrder, true, true>(lds, g, S, E); }
        xcd_barrier(xbar);
        { KA a = ARGS(); ln_phase(a->out, (bf16*)(a->ws + WS_ACT), a->in[I_LN1W] + l * D, a->in[I_LN1B] + l * D, false, true); }
        xcd_barrier(xbar);
        { KA a = ARGS(); unsigned char* ws = a->ws;
          pg8::Gemm g{(const bf16*)(ws + WS_ACT), (const bf16*)(ws + WS_WGU + l * WGU_STRIDE), T, FF2, D}; pg8::StaticOrder S; S.init(T, FF2, gridDim.x, blockIdx.x, WGM_F1);
          EpiSwiGLU E{(bf16*)(ws + WS_H)}; pg8::gemm_phase<EpiSwiGLU, pg8::StaticOrder, true, true>(lds, g, S, E);
#ifdef REP_GEMM
          pg8::gemm_phase<EpiSwiGLU, pg8::StaticOrder, true, true>(lds, g, S, E);
#endif
        }
        xcd_barrier(xbar);
        { KA a = ARGS(); unsigned char* ws = a->ws;
          pg8::Gemm g{(const bf16*)(ws + WS_H), (const bf16*)(ws + WS_WD + l * WD_STRIDE), T, D, FF}; pg8::StaticOrder S; S.init(T, D, gridDim.x, blockIdx.x, WGM_N1K);
          EpiResB E{(const bf16*)(ws + WS_ACT), a->out}; pg8::gemm_phase<EpiResB, pg8::StaticOrder, true, true>(lds, g, S, E); }
        xcd_barrier(xbar);
        { KA a = ARGS(); ln_phase(a->out, (bf16*)(a->ws + WS_ACT), a->in[I_LN2W] + l * D, a->in[I_LN2B] + l * D, true, l == 0); }
        if (l == 0) xcd_barrier(xbar);
    }
}

extern "C" void kernel_launch(void* const* d_in, const int* in_sizes, int n_in, void* d_out, int out_size, void* d_ws, size_t ws_size, hipStream_t stream) {
    static int grid = 0;
    if (grid == 0) {
        if (n_in != 35 || out_size != T * D || ws_size < WS_END) { fprintf(stderr, "kernel_launch: unexpected shapes (n_in %d out %d ws %zu)\n", n_in, out_size, ws_size); grid = -1; return; }
        int dev = 0, cus = 0, per_cu = 0;
        hipGetDevice(&dev); hipDeviceGetAttribute(&cus, hipDeviceAttributeMultiprocessorCount, dev);
        if (hipFuncSetAttribute((const void*)fwd_megakernel, hipFuncAttributeMaxDynamicSharedMemorySize, LDS_BYTES) != hipSuccess) { fprintf(stderr, "kernel_launch: hipFuncSetAttribute failed\n"); grid = -1; return; }
        if (hipOccupancyMaxActiveBlocksPerMultiprocessor(&per_cu, (const void*)fwd_megakernel, NTHR, LDS_BYTES) != hipSuccess || per_cu < 1) { fprintf(stderr, "kernel_launch: occupancy query says %d\n", per_cu); per_cu = 1; }
        (void)hipGetLastError();
        grid = cus;
    }
    if (grid < 0) return;
    Args a{};
    for (int i = 0; i < 35; ++i) a.in[i] = (const float*)d_in[i];
    a.out = (float*)d_out; a.ws = (unsigned char*)d_ws;
    void* args[] = {&a};
    hipError_t e = hipLaunchCooperativeKernel((const void*)fwd_megakernel, dim3(grid), dim3(NTHR), args, LDS_BYTES, stream);
    if (e != hipSuccess) fprintf(stderr, "cooperative launch failed: %s (grid %d)\n", hipGetErrorString(e), grid);
}
```

```cpp
#include <hip/hip_runtime.h>
#include <hip/hip_cooperative_groups.h>
#include <cstdio>
#include <cstdint>
namespace cg = cooperative_groups;
__device__ __forceinline__ int tid_() { int t = threadIdx.x; asm volatile("" : "+v"(t)); return t; }
namespace pg8 {
#define PG8_LAS __attribute__((address_space(3)))
typedef unsigned short bf16_t;
typedef short bf16x8 __attribute__((ext_vector_type(8)));
typedef float f32x4 __attribute__((ext_vector_type(4)));
typedef unsigned u32x4 __attribute__((ext_vector_type(4)));
constexpr int BM = 256, BK = 64, HALF = 128, HTB = HALF * BK * 2  , STAGE_BYTES = 8 * HTB, NXCD = 8, WGM = 8;

__host__ __device__ __forceinline__ int lds_byte(int r, int c) { const int st = (r >> 4) * 2 + (c >> 5), rr = r & 15, cc = c & 31, ob = rr * 64 + cc * 2; return st * 1024 + (ob ^ (((ob >> 9) & 1) << 5)); }
__host__ __device__ __forceinline__ void stage_rc(int b, int& R, int& C) { const int st = b / 1024, sb = b % 1024, swz = sb ^ (((sb >> 9) & 1) << 5); R = (st >> 1) * 16 + swz / 64; C = (st & 1) * 32 + (swz % 64) / 2; }
__host__ __device__ __forceinline__ int perm32(int rho) { const int n = rho >> 4, i = rho & 15; return 8 * (i >> 2) + 4 * n + (i & 3); }

struct Unit { int pm, pn; };
struct Gemm { const bf16_t* A; const bf16_t* Bt; int M, N, K; };

struct StaticOrder {
    int nM, nN, nwg, G, c, wgm;
    __host__ __device__ void init(int M, int N, int G_, int c_, int wgm_ = WGM) { nM = M / BM; nN = N / BM; nwg = nM * nN; G = G_; c = c_; wgm = wgm_; }
    __host__ __device__ bool next(int i, Unit& u) const {
        const long L = (long)i * G + c; if (L >= nwg) return false;
        int wgid = (int)L; { const int q = nwg / NXCD, r = nwg % NXCD, xcd = wgid % NXCD, off = wgid / NXCD; wgid = (xcd < r ? xcd * (q + 1) : r * (q + 1) + (xcd - r) * q) + off; }
        const int nig = wgm * nN, gid = wgid / nig, fm = gid * wgm, gsz = (nM - fm) < wgm ? (nM - fm) : wgm;
        u.pm = fm + ((wgid % nig) % gsz); u.pn = (wgid % nig) / gsz; return true;
    }
    __device__ __forceinline__ void a_ready(const Unit&) const {}
    __device__ __forceinline__ void done(const Unit&) const {}
};

__device__ __forceinline__ unsigned cvt_pk_bf16(float lo, float hi) { unsigned r; asm volatile("v_cvt_pk_bf16_f32 %0, %1, %2" : "=v"(r) : "v"(lo), "v"(hi)); return r; }
template <class Epi, class Sched, bool ALIGN_EPI = false, bool SP2 = false>
__device__ __forceinline__ void gemm_phase(PG8_LAS unsigned char* lds, const Gemm g, const Sched& S, const Epi& E) {
    const int tid = tid_(), wid = __builtin_amdgcn_readfirstlane(tid >> 6), lane = tid & 63, wr = wid >> 2, wc = wid & 3, fr = lane & 15, fq = lane >> 4;
    const int K = g.K, nt = K / BK;
    unsigned voffA[2], voffB[2];
#pragma unroll
    for (int i = 0; i < 2; ++i) { int R, C; stage_rc(tid * 16 + i * 8192, R, C); const int Rb = Epi::PERM ? ((R & ~31) + perm32(R & 31)) : R;
        voffA[i] = (unsigned)(R * K + C) * 2u; voffB[i] = (unsigned)(Rb * K + C) * 2u; }
    const size_t kstep = (size_t)(BK * 2);
    const size_t hstep = (size_t)HALF * K * 2;
    const size_t tstep = 2 * hstep;
    const unsigned ldsw = (unsigned)wid * 1024u;
    const int aoff = lds_byte(wr * 64 + fr, fq * 8), boff = lds_byte(wc * 32 + fr, fq * 8);
#define PG8_SA(b, h) (((b) * 2 + (h)) * HTB)
#define PG8_SB(b, h) ((4 + (b) * 2 + (h)) * HTB)
#define PG8_STAGE(bufoff, gbase, voff) do { _Pragma("unroll") for (int _i = 0; _i < 2; ++_i) \
        __builtin_amdgcn_global_load_lds((const unsigned*)((const char*)(gbase) + (voff)[_i]), (PG8_LAS unsigned*)(lds + (bufoff) + ldsw + _i * 8192), 16, 0, 0); } while (0)
#define PG8_LDA(dst, b, h) do { _Pragma("unroll") for (int m = 0; m < 4; ++m) _Pragma("unroll") for (int k = 0; k < 2; ++k) dst[m][k] = *(const PG8_LAS bf16x8*)(lds + PG8_SA(b, h) + aoff + m * 2048 + k * 1024); } while (0)
#define PG8_LDB(dst, b, h) do { _Pragma("unroll") for (int n = 0; n < 2; ++n) _Pragma("unroll") for (int k = 0; k < 2; ++k) dst[n][k] = *(const PG8_LAS bf16x8*)(lds + PG8_SB(b, h) + boff + n * 2048 + k * 1024); } while (0)
#define PG8_MMA(ai, bj, At, Bt) do { __builtin_amdgcn_s_setprio(1); _Pragma("unroll") for (int m = 0; m < 4; ++m) _Pragma("unroll") for (int n = 0; n < 2; ++n) _Pragma("unroll") for (int k = 0; k < 2; ++k) \
        acc[ai][bj][m][n] = __builtin_amdgcn_mfma_f32_16x16x32_bf16(Bt[n][k], At[m][k], acc[ai][bj][m][n], 0, 0, 0); __builtin_amdgcn_s_setprio(0); } while (0)
#define PG8_WAIT_V(n) asm volatile("s_waitcnt vmcnt(" #n ")" ::: "memory")
#define PG8_WAIT_L(n) asm volatile("s_waitcnt lgkmcnt(" #n ")" ::: "memory")
#define PG8_BAR __builtin_amdgcn_s_barrier()
#define PG8_SCHED __builtin_amdgcn_sched_barrier(0)
    Unit cur, nxt; int ui = 0;
    if (!S.next(0, cur)) return;
    f32x4 acc[2][2][4][2];
#pragma unroll
    for (int a = 0; a < 2; ++a)
#pragma unroll
        for (int b = 0; b < 2; ++b)
#pragma unroll
            for (int m = 0; m < 4; ++m)
#pragma unroll
                for (int n = 0; n < 2; ++n) acc[a][b][m][n] = (f32x4){0.f, 0.f, 0.f, 0.f};
    bf16x8 At[4][2], B0[2][2], B1[2][2];
    const char* cA = (const char*)g.A + (size_t)cur.pm * tstep; const char* cB = (const char*)g.Bt + (size_t)cur.pn * tstep;
    S.a_ready(cur);
    if constexpr (SP2) {
        PG8_STAGE(PG8_SB(0, 0), cB, voffB); PG8_STAGE(PG8_SB(0, 1), cB + hstep, voffB); PG8_STAGE(PG8_SA(0, 0), cA, voffA); PG8_STAGE(PG8_SA(0, 1), cA + hstep, voffA);
        if (wr == 1) PG8_BAR;
        PG8_WAIT_V(2); PG8_BAR;
        PG8_STAGE(PG8_SB(1, 0), cB + kstep, voffB); PG8_STAGE(PG8_SA(1, 0), cA + kstep, voffA); PG8_STAGE(PG8_SB(1, 1), cB + hstep + kstep, voffB);
        PG8_WAIT_V(6); PG8_BAR;
    } else {
        PG8_STAGE(PG8_SB(0, 0), cB, voffB); PG8_STAGE(PG8_SA(0, 0), cA, voffA); PG8_STAGE(PG8_SB(0, 1), cB + hstep, voffB); PG8_STAGE(PG8_SA(0, 1), cA + hstep, voffA);
        if (wr == 1) PG8_BAR;
        PG8_WAIT_V(4); PG8_BAR;
        PG8_STAGE(PG8_SB(1, 0), cB + kstep, voffB); PG8_STAGE(PG8_SA(1, 0), cA + kstep, voffA); PG8_STAGE(PG8_SB(1, 1), cB + hstep + kstep, voffB);
        PG8_WAIT_V(6); PG8_BAR;
    }
    for (;;) {
        const bool has_next = S.next(ui + 1, nxt);
        const char* nA = has_next ? (const char*)g.A + (size_t)nxt.pm * tstep : cA; const char* nB = has_next ? (const char*)g.Bt + (size_t)nxt.pn * tstep : cB;
        for (int t = 0; t < nt; t += 2) {
            const bool last = (t == nt - 2);
            const char* a1 = cA + (size_t)(t + 1) * kstep;
            const char* a2 = last ? nA : cA + (size_t)(t + 2) * kstep; const char* b2 = last ? nB : cB + (size_t)(t + 2) * kstep;
            const char* a3 = a2 + kstep; const char* b3 = b2 + kstep;
            if (last && has_next) S.a_ready(nxt);
            if constexpr (SP2) {
            PG8_LDB(B0, 0, 0); PG8_LDB(B1, 0, 1); PG8_SCHED; PG8_LDA(At, 0, 0); PG8_STAGE(PG8_SA(1, 1), a1 + hstep, voffA);
            PG8_WAIT_V(8); PG8_WAIT_L(0); PG8_BAR; PG8_MMA(0, 0, At, B0); PG8_MMA(0, 1, At, B1); PG8_BAR; PG8_SCHED;
            PG8_LDA(At, 0, 1); PG8_STAGE(PG8_SB(0, 0), b2, voffB); PG8_STAGE(PG8_SB(0, 1), b2 + hstep, voffB); PG8_STAGE(PG8_SA(0, 0), a2, voffA);
            PG8_WAIT_V(8); PG8_WAIT_L(0); PG8_BAR; PG8_MMA(1, 0, At, B0); PG8_MMA(1, 1, At, B1); PG8_BAR; PG8_SCHED;
            PG8_LDB(B0, 1, 0); PG8_LDB(B1, 1, 1); PG8_SCHED; PG8_LDA(At, 1, 0); PG8_STAGE(PG8_SA(0, 1), a2 + hstep, voffA);
            PG8_WAIT_V(8); PG8_WAIT_L(0); PG8_BAR; PG8_MMA(0, 0, At, B0); PG8_MMA(0, 1, At, B1); PG8_BAR; PG8_SCHED;
            PG8_LDA(At, 1, 1); PG8_STAGE(PG8_SB(1, 0), b3, voffB); PG8_STAGE(PG8_SB(1, 1), b3 + hstep, voffB); PG8_STAGE(PG8_SA(1, 0), a3, voffA);
            PG8_WAIT_V(8); PG8_WAIT_L(0); PG8_BAR; PG8_MMA(1, 0, At, B0); PG8_MMA(1, 1, At, B1); PG8_BAR; PG8_SCHED;
            } else {
            PG8_LDB(B0, 0, 0); PG8_SCHED; PG8_LDA(At, 0, 0); PG8_STAGE(PG8_SA(1, 1), a1 + hstep, voffA);
            PG8_WAIT_L(8); PG8_BAR; PG8_WAIT_L(0); PG8_MMA(0, 0, At, B0); PG8_BAR; PG8_SCHED;
            PG8_LDB(B1, 0, 1); PG8_STAGE(PG8_SB(0, 0), b2, voffB);
            PG8_BAR; PG8_WAIT_L(0); PG8_MMA(0, 1, At, B1); PG8_BAR;
            PG8_LDA(At, 0, 1); PG8_STAGE(PG8_SA(0, 0), a2, voffA);
            PG8_BAR; PG8_WAIT_L(0); PG8_MMA(1, 0, At, B0); PG8_BAR; PG8_SCHED;
            PG8_STAGE(PG8_SB(0, 1), b2 + hstep, voffB);
            PG8_WAIT_V(6); PG8_BAR; PG8_MMA(1, 1, At, B1); PG8_BAR;
            PG8_LDB(B0, 1, 0); PG8_SCHED; PG8_LDA(At, 1, 0); PG8_STAGE(PG8_SA(0, 1), a2 + hstep, voffA);
            PG8_WAIT_L(8); PG8_BAR; PG8_WAIT_L(0); PG8_MMA(0, 0, At, B0); PG8_BAR; PG8_SCHED;
            PG8_LDB(B1, 1, 1); PG8_STAGE(PG8_SB(1, 0), b3, voffB);
            PG8_BAR; PG8_WAIT_L(0); PG8_MMA(0, 1, At, B1); PG8_BAR;
            PG8_LDA(At, 1, 1); PG8_STAGE(PG8_SA(1, 0), a3, voffA);
            PG8_BAR; PG8_WAIT_L(0); PG8_MMA(1, 0, At, B0); PG8_BAR; PG8_SCHED;
            PG8_STAGE(PG8_SB(1, 1), b3 + hstep, voffB);
            PG8_WAIT_V(6); PG8_BAR; PG8_MMA(1, 1, At, B1); PG8_BAR;
            }
        }
        if constexpr (ALIGN_EPI) { if (wr == 0) PG8_BAR; }
        if constexpr (!Epi::AFTER_DRAIN) { E(acc, cur, wr, wc, fr, fq); S.done(cur); }
        if (!has_next) break;
#pragma unroll
        for (int a = 0; a < 2; ++a)
#pragma unroll
            for (int b = 0; b < 2; ++b)
#pragma unroll
                for (int m = 0; m < 4; ++m)
#pragma unroll
                    for (int n = 0; n < 2; ++n) acc[a][b][m][n] = (f32x4){0.f, 0.f, 0.f, 0.f};
        cur = nxt; cA = nA; cB = nB; ++ui;
        if constexpr (ALIGN_EPI) { if (wr == 1) PG8_BAR; }
    }
    PG8_WAIT_V(0);
    if constexpr (!ALIGN_EPI) { if (wr == 0) PG8_BAR; }
    PG8_BAR;
    if constexpr (Epi::AFTER_DRAIN) { E.fused(acc, cur, wr, wc, fr, fq, lds, wid, lane); S.done(cur); }
#undef PG8_SA
#undef PG8_SB
#undef PG8_STAGE
#undef PG8_LDA
#undef PG8_LDB
#undef PG8_MMA
#undef PG8_WAIT_V
#undef PG8_WAIT_L
#undef PG8_BAR
#undef PG8_SCHED
}
}
#define LAS __attribute__((address_space(3)))
typedef unsigned short bf16;
typedef unsigned v4u __attribute__((ext_vector_type(4)));
typedef unsigned v2u __attribute__((ext_vector_type(2)));
typedef float f32x4 __attribute__((ext_vector_type(4)));
typedef float f32x2 __attribute__((ext_vector_type(2)));
typedef float f32x16 __attribute__((ext_vector_type(16)));
typedef short bf16x8 __attribute__((ext_vector_type(8)));
typedef short s16x4 __attribute__((ext_vector_type(4)));
#define LDS_WAIT() asm volatile("s_waitcnt lgkmcnt(0)" ::: "memory")
#define DI __device__ __forceinline__

constexpr int NBATCH = 16, SEQ = 2048, T = NBATCH * SEQ, D = 1024, HP = 3584, FF = 2816, FF2 = 5632, NWAVES = 8, NTHR = 512;
constexpr float ALPHA = 1.4142135623730951f;
constexpr float LN_EPS = 1e-5f;
constexpr int C_GQ = 0, C_GK = 256, C_GV = 512, C_GG = 768, C_GA = 1024;
constexpr int C_RW = 1040;
constexpr int C_RR = 1040, C_RK = 1296, C_RV = 1552, C_RWL = 1808, C_RAL = 1872, C_RGL = 1936;
constexpr int C_NQ = 2096, C_NKC = 2608, C_NVC = 2736, C_NKS = 2864, C_NVS = 2992, C_NKW = 3120, C_NVW = 3248, C_NG = 3376, C_VR = 3400;
constexpr size_t MiB = 1u << 20;
constexpr size_t WS_CTL = 0, CTL_BYTES = 65536;
constexpr size_t WS_COS = 1 * MiB, WS_SIN = WS_COS + 256 * 1024;
constexpr size_t WS_KCMP = WS_COS + 512 * 1024, WS_VCMP = WS_KCMP + 512 * 1024;
constexpr size_t WS_SMALL = 3 * MiB, SMALL_STRIDE = 512 * 1024;
constexpr size_t SM_W2T = 0, SM_A2T = 32768, SM_G2T = 65536, SM_V2T = 65536 + 98304, SM_WK2T = SM_V2T + 32768, SM_WV2T = SM_WK2T + 32768;
constexpr size_t WS_WIN = 4 * MiB, WIN_STRIDE = 7 * MiB;
constexpr size_t WS_WOUT = 18 * MiB, WOUT_STRIDE = 2 * MiB;
constexpr size_t WS_WGU = 22 * MiB, WGU_STRIDE = 11 * MiB;
constexpr size_t WS_WD = 44 * MiB, WD_STRIDE = 11 * MiB / 2;
constexpr size_t WS_WC1 = 55 * MiB;
constexpr size_t WS_ACT = 64 * MiB, WS_H = 128 * MiB;
constexpr size_t WS_RW = 352 * MiB, WS_RR = 384 * MiB, WS_RK = 400 * MiB, WS_RV = 416 * MiB, WS_RA = 432 * MiB, WS_RB = 448 * MiB, WS_VF = 464 * MiB, WS_END = 480 * MiB;
#ifndef WGM_IN
#define WGM_IN 8
#endif
#ifndef WGM_F1
#define WGM_F1 8
#endif
#ifndef WGM_N1K
#define WGM_N1K 8
#endif
constexpr int LDS_BYTES = 153600;
constexpr int XB_LDS_OFF = 152000, CW_BAR = 4096;

struct Args { const float* in[35]; float* out; unsigned char* ws; };
typedef const __attribute__((address_space(4))) Args* KA;
#define ARGS() ({ KA _p = (KA)__builtin_amdgcn_kernarg_segment_ptr(); asm volatile("" : "+s"(_p)); _p; })
enum { I_X = 0, I_WIN, I_WINV, I_GLA_A2, I_GLA_BA, I_GLA_LNW, I_GLA_LNB, I_MU, I_MUV, I_W0, I_W2, I_A0, I_A2, I_V0, I_V2, I_G2, I_KK, I_KA, I_RK, I_RLNW, I_RLNB,
       I_POSK, I_POSV, I_WK1, I_WK2, I_WV1, I_WV2, I_WOUT, I_LN1W, I_LN1B, I_FG, I_FU, I_FD, I_LN2W, I_LN2B };

DI int bid_() { int t = blockIdx.x; asm volatile("" : "+s"(t)); return t; }
DI unsigned f2bf(float f) { unsigned u = __builtin_bit_cast(unsigned, f); return (u + 0x7fffu + ((u >> 16) & 1u)) >> 16; }
typedef __bf16 bf16x2_t __attribute__((ext_vector_type(2)));
DI unsigned pk2(float lo, float hi) { const f32x2 v = {lo, hi}; const bf16x2_t b = __builtin_convertvector(v, bf16x2_t); return __builtin_bit_cast(unsigned, b); }
DI float bf2f(unsigned short b) { return __builtin_bit_cast(float, (unsigned)b << 16); }
DI float bflo(unsigned u) { return __builtin_bit_cast(float, u << 16); }
DI float bfhi(unsigned u) { return __builtin_bit_cast(float, u & 0xffff0000u); }
template <int CTRL> DI float dpp_ror_add(float x) { return x + __builtin_bit_cast(float, __builtin_amdgcn_update_dpp(0, __builtin_bit_cast(int, x), CTRL, 0xF, 0xF, true)); }
DI float wave_sum(float v) {
    v = dpp_ror_add<0x128>(v); v = dpp_ror_add<0x124>(v); v = dpp_ror_add<0x122>(v); v = dpp_ror_add<0x121>(v);
    const int b = __builtin_bit_cast(int, v);
    const float r0 = __builtin_bit_cast(float, __builtin_amdgcn_readlane(b, 0)), r1 = __builtin_bit_cast(float, __builtin_amdgcn_readlane(b, 16));
    const float r2 = __builtin_bit_cast(float, __builtin_amdgcn_readlane(b, 32)), r3 = __builtin_bit_cast(float, __builtin_amdgcn_readlane(b, 48));
    return (r0 + r1) + (r2 + r3);
}
DI float fast_tanh(float x) { return 1.f - 2.f * __builtin_amdgcn_rcpf(1.f + __expf(2.f * x)); }
DI float sigmoidf_(float x) { return __builtin_amdgcn_rcpf(1.f + __expf(-x)); }

struct EpiH {
    static constexpr bool PERM = true, AFTER_DRAIN = false;
    bf16* O; int ldc;
    DI void operator()(const pg8::f32x4 (&acc)[2][2][4][2], const pg8::Unit& u, int wr, int wc, int fr, int fq) const {
        const int row0 = u.pm * 256 + wr * 64 + fr, col0 = u.pn * 256 + wc * 32 + 8 * fq;
#pragma unroll
        for (int ai = 0; ai < 2; ++ai)
#pragma unroll
            for (int m = 0; m < 4; ++m) { bf16* rowp = O + (size_t)(row0 + ai * 128 + m * 16) * ldc + col0;
#pragma unroll
                for (int bj = 0; bj < 2; ++bj) { const pg8::f32x4 v0 = acc[ai][bj][m][0], v1 = acc[ai][bj][m][1];
                    v4u w; w.x = pg8::cvt_pk_bf16(v0[0], v0[1]); w.y = pg8::cvt_pk_bf16(v0[2], v0[3]); w.z = pg8::cvt_pk_bf16(v1[0], v1[1]); w.w = pg8::cvt_pk_bf16(v1[2], v1[3]);
                    *(v4u*)(rowp + bj * 128) = w; } }
    }
};
struct EpiRes {
    static constexpr bool PERM = true, AFTER_DRAIN = false;
    const float* res; float* out;
    DI void operator()(const pg8::f32x4 (&acc)[2][2][4][2], const pg8::Unit& u, int wr, int wc, int fr, int fq) const {
        const int row0 = u.pm * 256 + wr * 64 + fr, col0 = u.pn * 256 + wc * 32 + 8 * fq;
#pragma unroll
        for (int ai = 0; ai < 2; ++ai) {
            f32x4 rv[4][2][2];
#pragma unroll
            for (int m = 0; m < 4; ++m) { const size_t off = (size_t)(row0 + ai * 128 + m * 16) * D + col0;
#pragma unroll
                for (int bj = 0; bj < 2; ++bj)
#pragma unroll
                    for (int n = 0; n < 2; ++n) rv[m][bj][n] = *(const f32x4*)(res + off + bj * 128 + 4 * n); }
#pragma unroll
            for (int m = 0; m < 4; ++m) { const size_t off = (size_t)(row0 + ai * 128 + m * 16) * D + col0;
#pragma unroll
                for (int bj = 0; bj < 2; ++bj)
#pragma unroll
                    for (int n = 0; n < 2; ++n) { const f32x4 r = rv[m][bj][n]; const pg8::f32x4 a = acc[ai][bj][m][n];
                        f32x4 o; o[0] = ALPHA * r[0] + a[0]; o[1] = ALPHA * r[1] + a[1]; o[2] = ALPHA * r[2] + a[2]; o[3] = ALPHA * r[3] + a[3];
                        *(f32x4*)(out + off + bj * 128 + 4 * n) = o; } }
        }
    }
};
struct EpiResB {
    static constexpr bool PERM = true, AFTER_DRAIN = false;
    const bf16* res; float* out;
    DI void operator()(const pg8::f32x4 (&acc)[2][2][4][2], const pg8::Unit& u, int wr, int wc, int fr, int fq) const {
        const int row0 = u.pm * 256 + wr * 64 + fr, col0 = u.pn * 256 + wc * 32 + 8 * fq;
        v4u rb[2][4][2];
#pragma unroll
        for (int ai = 0; ai < 2; ++ai)
#pragma unroll
            for (int m = 0; m < 4; ++m) { const size_t off = (size_t)(row0 + ai * 128 + m * 16) * D + col0;
#pragma unroll
                for (int bj = 0; bj < 2; ++bj) rb[ai][m][bj] = *(const v4u*)(res + off + bj * 128); }
#pragma unroll
        for (int ai = 0; ai < 2; ++ai)
#pragma unroll
            for (int m = 0; m < 4; ++m) { const size_t off = (size_t)(row0 + ai * 128 + m * 16) * D + col0;
#pragma unroll
                for (int bj = 0; bj < 2; ++bj) { const v4u q = rb[ai][m][bj]; const float r8[8] = {bflo(q.x), bfhi(q.x), bflo(q.y), bfhi(q.y), bflo(q.z), bfhi(q.z), bflo(q.w), bfhi(q.w)};
#pragma unroll
                    for (int n = 0; n < 2; ++n) { const pg8::f32x4 a = acc[ai][bj][m][n];
                        f32x4 o; o[0] = ALPHA * r8[4 * n] + a[0]; o[1] = ALPHA * r8[4 * n + 1] + a[1]; o[2] = ALPHA * r8[4 * n + 2] + a[2]; o[3] = ALPHA * r8[4 * n + 3] + a[3];
                        *(f32x4*)(out + off + bj * 128 + 4 * n) = o; } } }
    }
};
struct EpiSwiGLU {
    static constexpr bool PERM = true, AFTER_DRAIN = false;
    bf16* O;
    DI void operator()(const pg8::f32x4 (&acc)[2][2][4][2], const pg8::Unit& u, int wr, int wc, int fr, int fq) const {
        const int row0 = u.pm * 256 + wr * 64 + fr, col0 = u.pn * 128 + wc * 32 + 8 * fq;
#pragma unroll
        for (int ai = 0; ai < 2; ++ai)
#pragma unroll
            for (int m = 0; m < 4; ++m) { bf16* rowp = O + (size_t)(row0 + ai * 128 + m * 16) * FF + col0;
                float hv[8];
#pragma unroll
                for (int n = 0; n < 2; ++n)
#pragma unroll
                    for (int j = 0; j < 4; ++j) { const float g = acc[ai][0][m][n][j], up = acc[ai][1][m][n][j]; hv[4 * n + j] = g * __builtin_amdgcn_rcpf(1.f + __expf(-g)) * up; }
                v4u w; w.x = pg8::cvt_pk_bf16(hv[0], hv[1]); w.y = pg8::cvt_pk_bf16(hv[2], hv[3]); w.z = pg8::cvt_pk_bf16(hv[4], hv[5]); w.w = pg8::cvt_pk_bf16(hv[6], hv[7]);
                *(v4u*)rowp = w; }
    }
};

DI void tr_item(const float* W, int K, int N, bf16* WT, int ldt, int row_off, int mode, int kb, int nb, LAS float* scr, int lane) {
    const int k0 = 64 * kb, n0 = 32 * nb;
#pragma unroll
    for (int i = 0; i < 32; ++i) { const int kk = 2 * i + (lane >> 5), k = k0 + kk, n = n0 + (lane & 31); scr[kk * 33 + (lane & 31)] = (k < K && n < N) ? W[(size_t)k * N + n] : 0.f; }
    LDS_WAIT();
    const int c = lane & 7;
#pragma unroll
    for (int j = 0; j < 4; ++j) { const int nn = (lane >> 3) + 8 * j, n = n0 + nn; const LAS float* s = scr + (8 * c) * 33 + nn;
        v4u o; o.x = pk2(s[0 * 33], s[1 * 33]); o.y = pk2(s[2 * 33], s[3 * 33]); o.z = pk2(s[4 * 33], s[5 * 33]); o.w = pk2(s[6 * 33], s[7 * 33]);
        int dr = row_off + n; if (mode) dr = ((n >> 7) << 8) + (n & 127) + (mode == 2 ? 128 : 0);
        if (n < N && k0 + 8 * c + 8 <= ldt) *(v4u*)(WT + (size_t)dr * ldt + k0 + 8 * c) = o; }
    LDS_WAIT();
}
DI void tr_load(float (&v)[32], const float* W, int K, int N, int kb, int nb, int lane) {
    const int k0 = 64 * kb, n0 = 32 * nb;
#pragma unroll
    for (int i = 0; i < 32; ++i) { const int kk = 2 * i + (lane >> 5), k = k0 + kk, n = n0 + (lane & 31); v[i] = (k < K && n < N) ? W[(size_t)k * N + n] : 0.f; }
}
DI void tr_finish(const float (&v)[32], int N, bf16* WT, int ldt, int row_off, int mode, int kb, int nb, LAS float* scr, int lane) {
    const int k0 = 64 * kb, n0 = 32 * nb;
#pragma unroll
    for (int i = 0; i < 32; ++i) scr[(2 * i + (lane >> 5)) * 33 + (lane & 31)] = v[i];
    LDS_WAIT();
    const int c = lane & 7;
#pragma unroll
    for (int j = 0; j < 4; ++j) { const int nn = (lane >> 3) + 8 * j, n = n0 + nn; const LAS float* s = scr + (8 * c) * 33 + nn;
        v4u o; o.x = pk2(s[0 * 33], s[1 * 33]); o.y = pk2(s[2 * 33], s[3 * 33]); o.z = pk2(s[4 * 33], s[5 * 33]); o.w = pk2(s[6 * 33], s[7 * 33]);
        int dr = row_off + n; if (mode) dr = ((n >> 7) << 8) + (n & 127) + (mode == 2 ? 128 : 0);
        if (n < N && k0 + 8 * c + 8 <= ldt) *(v4u*)(WT + (size_t)dr * ldt + k0 + 8 * c) = o; }
    LDS_WAIT();
}
struct TrJob { const float* W; bf16* WT; int K, N, ldt, row_off, mode, nnb, start, pad; };
constexpr int PRO_JOBS_OFF = 140000;
DI void prologue(KA a, LAS unsigned char* lds) {
    const int tid = tid_(), lane = tid & 63, wave = tid >> 6, gw = blockIdx.x * NWAVES + wave, ngw = gridDim.x * NWAVES;
    LAS float* scr = (LAS float*)(lds + wave * 16384);
    unsigned char* ws = a->ws;
    LAS TrJob* jobs = (LAS TrJob*)(lds + PRO_JOBS_OFF); LAS int* njobs = (LAS int*)(lds + PRO_JOBS_OFF + 48 * 40);
    if (tid == 0) { int nj = 0, st = 0;
#define ADDJOB(W_, K_, N_, WT_, LDT_, RO_, MODE_) do { const int nkb_ = (((K_) > (LDT_) ? (K_) : (LDT_)) + 63) / 64, nnb_ = ((N_) + 31) / 32; \
        jobs[nj].W = (W_); jobs[nj].WT = (WT_); jobs[nj].K = (K_); jobs[nj].N = (N_); jobs[nj].ldt = (LDT_); jobs[nj].row_off = (RO_); jobs[nj].mode = (MODE_); jobs[nj].nnb = nnb_; jobs[nj].start = st; st += nkb_ * nnb_; ++nj; } while (0)
        for (int l = 0; l < 2; ++l) {
            bf16* winT = (bf16*)(ws + WS_WIN + l * WIN_STRIDE); unsigned char* sm = ws + WS_SMALL + l * SMALL_STRIDE;
            ADDJOB(a->in[I_WIN] + (size_t)l * D * 3400, D, 3400, winT, D, 0, 0);
            if (l == 1) ADDJOB(a->in[I_WINV], D, 32, winT, D, 3400, 0);
            ADDJOB(a->in[I_WOUT] + (size_t)l * D * D, D, D, (bf16*)(ws + WS_WOUT + l * WOUT_STRIDE), D, 0, 0);
            ADDJOB(a->in[I_FG] + (size_t)l * D * FF, D, FF, (bf16*)(ws + WS_WGU + l * WGU_STRIDE), D, 0, 1);
            ADDJOB(a->in[I_FU] + (size_t)l * D * FF, D, FF, (bf16*)(ws + WS_WGU + l * WGU_STRIDE), D, 0, 2);
            ADDJOB(a->in[I_FD] + (size_t)l * FF * D, FF, D, (bf16*)(ws + WS_WD + l * WD_STRIDE), FF, 0, 0);
            ADDJOB(a->in[I_WK1] + (size_t)l * 2048 * 256, 2048, 256, (bf16*)(ws + WS_WC1 + (l * 2 + 0) * MiB), 2048, 0, 0);
            ADDJOB(a->in[I_WV1] + (size_t)l * 2048 * 256, 2048, 256, (bf16*)(ws + WS_WC1 + (l * 2 + 1) * MiB), 2048, 0, 0);
            ADDJOB(a->in[I_W2] + (size_t)l * 64 * 256, 64, 256, (bf16*)(sm + SM_W2T), 64, 0, 0);
            ADDJOB(a->in[I_A2] + (size_t)l * 64 * 256, 64, 256, (bf16*)(sm + SM_A2T), 64, 0, 0);
            ADDJOB(a->in[I_G2] + (size_t)l * 160 * 256, 160, 256, (bf16*)(sm + SM_G2T), 192, 0, 0);
            if (l == 1) ADDJOB(a->in[I_V2], 32, 256, (bf16*)(sm + SM_V2T), 64, 0, 0);
            ADDJOB(a->in[I_WK2] + (size_t)l * 256 * 64, 256, 64, (bf16*)(sm + SM_WK2T), 256, 0, 0);
            ADDJOB(a->in[I_WV2] + (size_t)l * 256 * 64, 256, 64, (bf16*)(sm + SM_WV2T), 256, 0, 0);
        }
#undef ADDJOB
        jobs[nj].start = st; *njobs = nj; }
    __syncthreads();
    { const int nj = *njobs, total = jobs[nj].start;
      for (int it = gw; it < total; it += 2 * ngw) {
          const int itB = it + ngw; const bool hasB = itB < total;
          int jA = 0; while (jA + 1 < nj && jobs[jA + 1].start <= it) ++jA;
          int jB = jA; if (hasB) { while (jB + 1 < nj && jobs[jB + 1].start <= itB) ++jB; }
          const int rA = it - jobs[jA].start, nnbA = jobs[jA].nnb, rB = hasB ? itB - jobs[jB].start : 0, nnbB = jobs[jB].nnb;
          float vA[32], vB[32];
          tr_load(vA, jobs[jA].W, jobs[jA].K, jobs[jA].N, rA / nnbA, rA % nnbA, lane);
          if (hasB) tr_load(vB, jobs[jB].W, jobs[jB].K, jobs[jB].N, rB / nnbB, rB % nnbB, lane);
          tr_finish(vA, jobs[jA].N, jobs[jA].WT, jobs[jA].ldt, jobs[jA].row_off, jobs[jA].mode, rA / nnbA, rA % nnbA, scr, lane);
          if (hasB) tr_finish(vB, jobs[jB].N, jobs[jB].WT, jobs[jB].ldt, jobs[jB].row_off, jobs[jB].mode, rB / nnbB, rB % nnbB, scr, lane); } }
    for (int l = 0; l < 2; ++l) { bf16* winT = (bf16*)(ws + WS_WIN + l * WIN_STRIDE); const int r0 = (l == 1) ? 3432 : 3400; const int nchunk = (HP - r0) * (D / 8);
        for (int i = blockIdx.x * NTHR + tid; i < nchunk; i += gridDim.x * NTHR) *(v4u*)(winT + (size_t)r0 * D + (size_t)i * 8) = (v4u){0u, 0u, 0u, 0u}; }
#ifndef REP_ROPE
#define REP_ROPE 1
#endif
    for (int rr_ = 0; rr_ < REP_ROPE; ++rr_)
    { float* ct = (float*)(ws + WS_COS); float* st = (float*)(ws + WS_SIN);
      for (int i = blockIdx.x * NTHR + tid; i < SEQ * 32; i += gridDim.x * NTHR) { const int pos = i >> 5, f = i & 31;
          const float inv = powf(10000.f, -(float)f / 32.f); const float ang = (float)pos * inv; ct[i] = (float)cos((double)ang); st[i] = (float)sin((double)ang); } }
    { const float* x = a->in[I_X]; bf16* act = (bf16*)(ws + WS_ACT); const size_t stride = (size_t)gridDim.x * NTHR, n8 = (size_t)T * D / 8;
      for (size_t i = (size_t)blockIdx.x * NTHR + tid; i < n8; i += 4 * stride) { f32x4 v0[4], v1[4];
#pragma unroll
          for (int u = 0; u < 4; ++u) { const size_t ii = i + u * stride; if (ii < n8) { v0[u] = *(const f32x4*)(x + ii * 8); v1[u] = *(const f32x4*)(x + ii * 8 + 4); } }
#pragma unroll
          for (int u = 0; u < 4; ++u) { const size_t ii = i + u * stride; if (ii < n8) { v4u o; o.x = pk2(v0[u][0], v0[u][1]); o.y = pk2(v0[u][2], v0[u][3]); o.z = pk2(v1[u][0], v1[u][1]); o.w = pk2(v1[u][2], v1[u][3]); *(v4u*)(act + ii * 8) = o; } } } }
}
DI void ln_phase(float* io, bf16* act, const float* w, const float* b, const bool wr_f32, const bool wr_bf16) {
    const int tid = tid_(), lane = tid & 63, gw = blockIdx.x * NWAVES + (tid >> 6), ngw = gridDim.x * NWAVES;
    f32x4 nv[4];
    if (gw < T) { const f32x4* x0 = (const f32x4*)(io + (size_t)gw * D) + lane;
#pragma unroll
        for (int j = 0; j < 4; ++j) nv[j] = x0[64 * j]; }
    for (int r = gw; r < T; r += ngw) {
        f32x4* xr = (f32x4*)(io + (size_t)r * D) + lane; f32x4 v[4]; float s = 0.f;
#pragma unroll
        for (int j = 0; j < 4; ++j) { v[j] = nv[j]; s += (v[j][0] + v[j][1]) + (v[j][2] + v[j][3]); }
        if (r + ngw < T) { const f32x4* xn = (const f32x4*)(io + (size_t)(r + ngw) * D) + lane;
#pragma unroll
            for (int j = 0; j < 4; ++j) nv[j] = xn[64 * j]; }
        const float mean = wave_sum(s) * (1.f / D); float s2 = 0.f;
#pragma unroll
        for (int j = 0; j < 4; ++j) { v[j] = v[j] - mean; s2 += (v[j][0] * v[j][0] + v[j][1] * v[j][1]) + (v[j][2] * v[j][2] + v[j][3] * v[j][3]); }
        const float rstd = 1.f / sqrtf(wave_sum(s2) * (1.f / D) + LN_EPS);
        v2u* o8 = (v2u*)(act + (size_t)r * D) + lane;
#pragma unroll
        for (int j = 0; j < 4; ++j) { const f32x4 wv = ((const f32x4*)w)[lane + 64 * j], bv = ((const f32x4*)b)[lane + 64 * j];
            f32x4 y; y[0] = v[j][0] * rstd * wv[0] + bv[0]; y[1] = v[j][1] * rstd * wv[1] + bv[1]; y[2] = v[j][2] * rstd * wv[2] + bv[2]; y[3] = v[j][3] * rstd * wv[3] + bv[3];
            if (wr_f32) xr[64 * j] = y; if (wr_bf16) { v2u p; p.x = pk2(y[0], y[1]); p.y = pk2(y[2], y[3]); o8[64 * j] = p; } }
    }
}
#define XB_TMO      128
#define XB_XCNT(j)  (256  + 64 * (j))
#define XB_XSUB(j)  (1280 + 64 * (j))
#define XB_XGEN(j)  (2304 + 64 * (j))
#define XB_TOP      3328
#define XB_TOPGEN   3392
#define XCD_BAR_WORDS 3456
#define XB_SPIN_CAP (1u << 18)

__device__ __forceinline__ unsigned xb_ld(unsigned* p)              { return __hip_atomic_load(p, __ATOMIC_RELAXED, __HIP_MEMORY_SCOPE_AGENT); }
__device__ __forceinline__ unsigned xb_add(unsigned* p, unsigned v) { return __hip_atomic_fetch_add(p, v, __ATOMIC_RELAXED, __HIP_MEMORY_SCOPE_AGENT); }
__device__ __forceinline__ unsigned xb_xcc_id() { return (unsigned)__builtin_amdgcn_s_getreg((3 << 11) | 20) & 0xFu; }
#define XB_SPIN(cond, bar) do { unsigned _sp = 0; while (cond) { __builtin_amdgcn_s_sleep(1); \
    if ((++_sp & 255u) == 0u) { if (xb_ld(&(bar)[XB_TMO])) break; if (_sp > XB_SPIN_CAP) { atomicAdd(&(bar)[XB_TMO], 1u); break; } } } } while (0)

struct XcdBarrier {
    unsigned* bar; unsigned x;
    volatile LAS unsigned* st;
};

__device__ __forceinline__ XcdBarrier xcd_barrier_post(unsigned* bar, volatile LAS unsigned* st) {
    XcdBarrier b; b.bar = bar; b.x = xb_xcc_id(); b.st = st;
    if (threadIdx.x == 0) (void)xb_add(&bar[XB_XCNT(b.x)], 1u);
    return b;
}
__device__ __forceinline__ void xcd_barrier_complete(unsigned* bar, unsigned x, unsigned& nloc, unsigned& nx) {
    const unsigned G = gridDim.x * gridDim.y * gridDim.z;
    unsigned sum, cnt, mine, sp = 0u;
    for (;;) {
        sum = 0u; cnt = 0u; mine = 0u;
#pragma unroll
        for (unsigned j = 0; j < 16; ++j) { const unsigned c = xb_ld(&bar[XB_XCNT(j)]); sum += c; cnt += (c > 0u) ? 1u : 0u; mine = (j == x) ? c : mine; }
        if (sum == G) break;
        __builtin_amdgcn_s_sleep(1);
        if ((++sp & 255u) == 0u) { if (xb_ld(&bar[XB_TMO])) break; if (sp > XB_SPIN_CAP) { atomicAdd(&bar[XB_TMO], 1u); break; } }
    }
    nloc = mine > 0u ? mine : 1u; nx = cnt > 0u ? cnt : 1u;
}

__device__ __forceinline__ void xcd_barrier(const XcdBarrier& b) {
    asm volatile("s_waitcnt vmcnt(0)" ::: "memory");
    __syncthreads();
    if (threadIdx.x == 0) {
        unsigned* bar = b.bar;
        __builtin_amdgcn_s_waitcnt(0);
        unsigned nloc = b.st[0], nx = b.st[1];
        if (nloc == 0u) { xcd_barrier_complete(bar, b.x, nloc, nx); b.st[0] = nloc; b.st[1] = nx; }
        const unsigned old = xb_add(&bar[XB_XSUB(b.x)], 1u);
        const unsigned gen = old / nloc;
        if (old + 1u == (gen + 1u) * nloc) {
            __builtin_amdgcn_fence(__ATOMIC_RELEASE, "agent");
            asm volatile("s_waitcnt vmcnt(0)" ::: "memory");
            const unsigned og = xb_add(&bar[XB_TOP], 1u);
            const unsigned tg = og / nx;
            if (og + 1u == (tg + 1u) * nx) xb_add(&bar[XB_TOPGEN], 1u);
            else XB_SPIN(xb_ld(&bar[XB_TOPGEN]) == tg, bar);
            __builtin_amdgcn_fence(__ATOMIC_ACQUIRE, "agent");
            xb_add(&bar[XB_XGEN(b.x)], 1u);
            asm volatile("s_waitcnt vmcnt(0)" ::: "memory");
        } else {
            XB_SPIN(xb_ld(&bar[XB_XGEN(b.x)]) == gen, bar);
            __builtin_amdgcn_fence(__ATOMIC_ACQUIRE, "agent");
            asm volatile("s_waitcnt vmcnt(0)" ::: "memory");
        }
    }
    __syncthreads();
}
DI f32x4 mma16(bf16x8 a, bf16x8 b, f32x4 c) { return __builtin_amdgcn_mfma_f32_16x16x32_bf16(a, b, c, 0, 0, 0); }
DI f32x16 mma32(bf16x8 a, bf16x8 b, f32x16 c) { return __builtin_amdgcn_mfma_f32_32x32x16_bf16(a, b, c, 0, 0, 0); }
DI void unpack8(const v4u u, float (&f)[8]) { f[0] = bflo(u.x); f[1] = bfhi(u.x); f[2] = bflo(u.y); f[3] = bfhi(u.y); f[4] = bflo(u.z); f[5] = bfhi(u.z); f[6] = bflo(u.w); f[7] = bfhi(u.w); }
DI v4u pack8(const float (&f)[8]) { v4u o; o.x = pk2(f[0], f[1]); o.y = pk2(f[2], f[3]); o.z = pk2(f[4], f[5]); o.w = pk2(f[6], f[7]); return o; }
DI float ldbf(const bf16* p) { return bf2f(*p); }
constexpr int PA = 72;
#define ZERO4 ((f32x4){0.f, 0.f, 0.f, 0.f})
DI float red16(float v) { v += __shfl_xor(v, 1); v += __shfl_xor(v, 2); v += __shfl_xor(v, 4); v += __shfl_xor(v, 8); return v; }

DI void rwkv_prep_item(KA a, const int l, LAS unsigned char* lds, const int tile) {
    const int tid = tid_(), lane = tid & 63, w = tid >> 6, fr = lane & 15, fq = lane >> 4;
    unsigned char* ws = a->ws;
    const bf16* H = (const bf16*)(ws + WS_H);
    LAS bf16* Aw = (LAS bf16*)lds; LAS bf16* Aa = Aw + 64 * PA; LAS bf16* Av = Aa + 64 * PA;
    const int t0 = tile * 64;
    const float* mu = a->in[I_MU] + l * 1056;
    __syncthreads();
    {   const int tk = tid >> 3, c0 = (tid & 7) * 8, t = t0 + tk; const bool first = (t & (SEQ - 1)) == 0;
        const bf16* hr = H + (size_t)t * HP;
        float cu[8], pv[8], o[8];
        unpack8(*(const v4u*)(hr + C_RWL + c0), cu); if (first) { for (int e = 0; e < 8; ++e) pv[e] = 0.f; } else unpack8(*(const v4u*)(hr - HP + C_RWL + c0), pv);
#pragma unroll
        for (int e = 0; e < 8; ++e) o[e] = fast_tanh(cu[e] + (pv[e] - cu[e]) * mu[768 + c0 + e]);
        *(LAS v4u*)(Aw + tk * PA + c0) = pack8(o);
        unpack8(*(const v4u*)(hr + C_RAL + c0), cu); if (first) { for (int e = 0; e < 8; ++e) pv[e] = 0.f; } else unpack8(*(const v4u*)(hr - HP + C_RAL + c0), pv);
#pragma unroll
        for (int e = 0; e < 8; ++e) o[e] = cu[e] + (pv[e] - cu[e]) * mu[832 + c0 + e];
        *(LAS v4u*)(Aa + tk * PA + c0) = pack8(o);
        if (l == 1 && (tid & 7) < 4) { const float* muv = a->in[I_MUV];
            unpack8(*(const v4u*)(hr + C_VR + c0), cu); if (first) { for (int e = 0; e < 8; ++e) pv[e] = 0.f; } else unpack8(*(const v4u*)(hr - HP + C_VR + c0), pv);
#pragma unroll
            for (int e = 0; e < 8; ++e) o[e] = cu[e] + (pv[e] - cu[e]) * muv[c0 + e];
            *(LAS v4u*)(Av + tk * PA + c0) = pack8(o); }
    }
    __syncthreads();
    const int hd = w >> 1, th = w & 1;
    f32x4 accw[4][2], acca[4][2], accv[4][2];
#pragma unroll
    for (int ct = 0; ct < 4; ++ct)
#pragma unroll
        for (int rt = 0; rt < 2; ++rt) { accw[ct][rt] = ZERO4; acca[ct][rt] = ZERO4; accv[ct][rt] = ZERO4; }
    const bf16* w2T = (const bf16*)(ws + WS_SMALL + l * SMALL_STRIDE + SM_W2T); const bf16* a2T = (const bf16*)(ws + WS_SMALL + l * SMALL_STRIDE + SM_A2T); const bf16* v2T = (const bf16*)(ws + WS_SMALL + l * SMALL_STRIDE + SM_V2T);
#pragma unroll
    for (int ks = 0; ks < 2; ++ks) {
        bf16x8 afw[2], afa[2];
#pragma unroll
        for (int rt = 0; rt < 2; ++rt) { afw[rt] = *(const LAS bf16x8*)(Aw + (32 * th + 16 * rt + fr) * PA + ks * 32 + fq * 8); afa[rt] = *(const LAS bf16x8*)(Aa + (32 * th + 16 * rt + fr) * PA + ks * 32 + fq * 8); }
#pragma unroll
        for (int ct = 0; ct < 4; ++ct) { const size_t ro = (size_t)(hd * 64 + ct * 16 + fr) * 64 + ks * 32 + fq * 8;
            const bf16x8 bw = *(const bf16x8*)(w2T + ro), ba = *(const bf16x8*)(a2T + ro);
#pragma unroll
            for (int rt = 0; rt < 2; ++rt) { accw[ct][rt] = mma16(bw, afw[rt], accw[ct][rt]); acca[ct][rt] = mma16(ba, afa[rt], acca[ct][rt]); } }
    }
    if (l == 1) {
        bf16x8 afv[2];
#pragma unroll
        for (int rt = 0; rt < 2; ++rt) afv[rt] = *(const LAS bf16x8*)(Av + (32 * th + 16 * rt + fr) * PA + fq * 8);
#pragma unroll
        for (int ct = 0; ct < 4; ++ct) { const bf16x8 bv = *(const bf16x8*)(v2T + (size_t)(hd * 64 + ct * 16 + fr) * 64 + fq * 8);
#pragma unroll
            for (int rt = 0; rt < 2; ++rt) accv[ct][rt] = mma16(bv, afv[rt], accv[ct][rt]); }
    }
    const float* w0 = a->in[I_W0] + l * 256; const float* a0 = a->in[I_A0] + l * 256; const float* kkw = a->in[I_KK] + l * 256; const float* kaw = a->in[I_KA] + l * 256; const float* v0 = a->in[I_V0];
    float kx[2][4][4], ss[2] = {0.f, 0.f};
#pragma unroll
    for (int rt = 0; rt < 2; ++rt) { const int tk = t0 + 32 * th + 16 * rt + fr; const bool first = (tk & (SEQ - 1)) == 0;
#pragma unroll
        for (int ct = 0; ct < 4; ++ct) { const int c4 = hd * 64 + ct * 16 + 4 * fq; const f32x4 muk = *(const f32x4*)(mu + 256 + c4), kk4 = *(const f32x4*)(kkw + c4);
            const bf16* hp = H + (size_t)tk * HP + C_RK + c4; const v2u cu = *(const v2u*)hp; v2u pv = {0u, 0u}; if (!first) pv = *(const v2u*)(hp - HP);
            const float c_[4] = {bflo(cu.x), bfhi(cu.x), bflo(cu.y), bfhi(cu.y)}, p_[4] = {bflo(pv.x), bfhi(pv.x), bflo(pv.y), bfhi(pv.y)};
#pragma unroll
            for (int j = 0; j < 4; ++j) { const float k = c_[j] + (p_[j] - c_[j]) * muk[j]; kx[rt][ct][j] = k; const float kk = k * kk4[j]; ss[rt] += kk * kk; } } }
#pragma unroll
    for (int rt = 0; rt < 2; ++rt) { float s_ = ss[rt]; s_ += __shfl_xor(s_, 16); s_ += __shfl_xor(s_, 32); ss[rt] = 1.f / fmaxf(sqrtf(s_), 1e-12f); }
    float* Rw = (float*)(ws + WS_RW); bf16* Rr = (bf16*)(ws + WS_RR); bf16* Rk = (bf16*)(ws + WS_RK); bf16* Rv = (bf16*)(ws + WS_RV); bf16* Ra = (bf16*)(ws + WS_RA); bf16* Rb = (bf16*)(ws + WS_RB); bf16* VF = (bf16*)(ws + WS_VF);
#pragma unroll
    for (int rt = 0; rt < 2; ++rt) { const int tk = t0 + 32 * th + 16 * rt + fr; const bool first = (tk & (SEQ - 1)) == 0;
#pragma unroll
        for (int ct = 0; ct < 4; ++ct) { const int c4 = hd * 64 + ct * 16 + 4 * fq; const size_t ro = (size_t)tk * 256 + c4;
            const f32x4 mur = *(const f32x4*)(mu + c4), muv4 = *(const f32x4*)(mu + 512 + c4), w04 = *(const f32x4*)(w0 + c4), a04 = *(const f32x4*)(a0 + c4), kk4 = *(const f32x4*)(kkw + c4), ka4 = *(const f32x4*)(kaw + c4);
            f32x4 v04 = ZERO4; if (l == 1) v04 = *(const f32x4*)(v0 + c4);
            const bf16* hpr = H + (size_t)tk * HP + C_RR + c4; const bf16* hpv = H + (size_t)tk * HP + C_RV + c4;
            const v2u cr = *(const v2u*)hpr, cv = *(const v2u*)hpv; v2u pr = {0u, 0u}, pvv = {0u, 0u}; if (!first) { pr = *(const v2u*)(hpr - HP); pvv = *(const v2u*)(hpv - HP); }
            v2u vf2 = {0u, 0u}; if (l == 1) vf2 = *(const v2u*)(VF + ro);
            const float cr_[4] = {bflo(cr.x), bfhi(cr.x), bflo(cr.y), bfhi(cr.y)}, pr_[4] = {bflo(pr.x), bfhi(pr.x), bflo(pr.y), bfhi(pr.y)};
            const float cv_[4] = {bflo(cv.x), bfhi(cv.x), bflo(cv.y), bfhi(cv.y)}, pv_[4] = {bflo(pvv.x), bfhi(pvv.x), bflo(pvv.y), bfhi(pvv.y)}, vf_[4] = {bflo(vf2.x), bfhi(vf2.x), bflo(vf2.y), bfhi(vf2.y)};
            float o_r[4], o_k[4], o_v[4], o_a[4], o_b[4]; f32x4 o_w;
#pragma unroll
            for (int j = 0; j < 4; ++j) { const float r = cr_[j] + (pr_[j] - cr_[j]) * mur[j]; float v = cv_[j] + (pv_[j] - cv_[j]) * muv4[j];
                if (l == 1) v = v + (vf_[j] - v) * sigmoidf_(v04[j] + accv[ct][rt][j]);
                const float av = sigmoidf_(a04[j] + acca[ct][rt][j]);
                o_w[j] = __expf(-0.6065306597126334f * sigmoidf_(w04[j] + accw[ct][rt][j]));
                const float k = kx[rt][ct][j]; const float kkn = k * kk4[j] * ss[rt];
                o_r[j] = r; o_k[j] = k * (1.f + (av - 1.f) * ka4[j]); o_v[j] = v; o_a[j] = -kkn; o_b[j] = kkn * av; }
            *(f32x4*)(Rw + ro) = o_w;
#define ST4(P_, A_) do { v2u q_; q_.x = pk2(A_[0], A_[1]); q_.y = pk2(A_[2], A_[3]); *(v2u*)((P_) + ro) = q_; } while (0)
            ST4(Rr, o_r); ST4(Rk, o_k); ST4(Rv, o_v); ST4(Ra, o_a); ST4(Rb, o_b); if (l == 0) ST4(VF, o_v);
        } }
}

template <int CTRL> DI float ror_add(float x) { return x + __builtin_bit_cast(float, __builtin_amdgcn_update_dpp(0, __builtin_bit_cast(int, x), CTRL, 0xF, 0xF, true)); }
DI float allred16(float d) { d = ror_add<0x128>(d); d = ror_add<0x124>(d); d = ror_add<0x122>(d); d = ror_add<0x121>(d); return d; }
constexpr int SC = 32;
constexpr int SBUF_F = 5 * SC * 64 + SC * 32;
DI void rwkv_scan_item(KA a, LAS unsigned char* lds, const int item) {
    const int tid = tid_(), lane = tid & 63, w = tid >> 6, kl = lane & 15, rowl = w * 4 + (lane >> 4);
    const int half = item & 1, bh = item >> 1, hd = bh & 3, b = bh >> 2;
    unsigned char* ws = a->ws;
    const float* Rw = (const float*)(ws + WS_RW); const bf16* Rr = (const bf16*)(ws + WS_RR); const bf16* Rk = (const bf16*)(ws + WS_RK); const bf16* Rv = (const bf16*)(ws + WS_RV); const bf16* Ra = (const bf16*)(ws + WS_RA); const bf16* Rb = (const bf16*)(ws + WS_RB);
    bf16* H = (bf16*)(ws + WS_H);
    LAS float* sb = (LAS float*)lds;
    LAS float* yb = sb + 2 * SBUF_F;
    const int stk = tid >> 4, spart = tid & 15;
    const size_t gbase = (size_t)b * SEQ * 256 + hd * 64;
    f32x4 gw; v2u gr, gk, ga, gb; unsigned gv;
#define RW_LOAD(c) do { const size_t o_ = gbase + (size_t)((c) * SC + stk) * 256 + 4 * spart; gw = *(const f32x4*)(Rw + o_); gr = *(const v2u*)(Rr + o_); gk = *(const v2u*)(Rk + o_); ga = *(const v2u*)(Ra + o_); gb = *(const v2u*)(Rb + o_); \
        gv = *(const unsigned*)(Rv + gbase + (size_t)((c) * SC + stk) * 256 + half * 32 + 2 * spart); } while (0)
#define RW_STORE(bufi) do { LAS float* d_ = sb + (bufi) * SBUF_F; const int o_ = stk * 64 + 4 * spart; \
        *(LAS f32x4*)(d_ + o_) = (f32x4){bflo(gr.x), bfhi(gr.x), bflo(gr.y), bfhi(gr.y)}; *(LAS f32x4*)(d_ + SC * 64 + o_) = gw; \
        *(LAS f32x4*)(d_ + 2 * SC * 64 + o_) = (f32x4){bflo(gk.x), bfhi(gk.x), bflo(gk.y), bfhi(gk.y)}; *(LAS f32x4*)(d_ + 3 * SC * 64 + o_) = (f32x4){bflo(ga.x), bfhi(ga.x), bflo(ga.y), bfhi(ga.y)}; \
        *(LAS f32x4*)(d_ + 4 * SC * 64 + o_) = (f32x4){bflo(gb.x), bfhi(gb.x), bflo(gb.y), bfhi(gb.y)}; *(LAS f32x2*)(d_ + 5 * SC * 64 + stk * 32 + 2 * spart) = (f32x2){bflo(gv), bfhi(gv)}; } while (0)
    __syncthreads();
    RW_LOAD(0); RW_STORE(0);
    __syncthreads();
    f32x2 sA = {0.f, 0.f}, sB = {0.f, 0.f};
    constexpr int NCH = SEQ / SC;
    for (int c = 0; c < NCH; ++c) {
        if (c + 1 < NCH) RW_LOAD(c + 1);
        if (c > 0) {
            const LAS float* ys = yb + ((c - 1) & 1) * SC * 32 + (2 * spart) * SC + stk;
            *(unsigned*)(H + ((size_t)b * SEQ + (size_t)(c - 1) * SC + stk) * HP + C_RR + hd * 64 + half * 32 + 2 * spart) = pk2(ys[0], ys[SC]);
        }
        const LAS float* d_ = sb + (c & 1) * SBUF_F; LAS float* yo = yb + (c & 1) * SC * 32;
        for (int t4 = 0; t4 < SC; t4 += 4) {
            f32x4 R4[4], W4[4], K4[4], A4[4], B4[4]; float V1[4], yv[4];
#pragma unroll
            for (int u = 0; u < 4; ++u) { const int tt = t4 + u;
                R4[u] = *(const LAS f32x4*)(d_ + tt * 64 + 4 * kl); W4[u] = *(const LAS f32x4*)(d_ + SC * 64 + tt * 64 + 4 * kl); K4[u] = *(const LAS f32x4*)(d_ + 2 * SC * 64 + tt * 64 + 4 * kl);
                A4[u] = *(const LAS f32x4*)(d_ + 3 * SC * 64 + tt * 64 + 4 * kl); B4[u] = *(const LAS f32x4*)(d_ + 4 * SC * 64 + tt * 64 + 4 * kl); V1[u] = d_[5 * SC * 64 + tt * 32 + rowl]; }
#pragma unroll
            for (int u = 0; u < 4; ++u) {
                const f32x2 a01 = {A4[u][0], A4[u][1]}, a23 = {A4[u][2], A4[u][3]}, b01 = {B4[u][0], B4[u][1]}, b23 = {B4[u][2], B4[u][3]};
                const f32x2 k01 = {K4[u][0], K4[u][1]}, k23 = {K4[u][2], K4[u][3]}, w01 = {W4[u][0], W4[u][1]}, w23 = {W4[u][2], W4[u][3]}, r01 = {R4[u][0], R4[u][1]}, r23 = {R4[u][2], R4[u][3]};
                f32x2 p = sA * a01; p = sB * a23 + p;
                const float dsa = allred16(p[0] + p[1]);
                const f32x2 tA = k01 * V1[u] + b01 * dsa, tB = k23 * V1[u] + b23 * dsa;
                sA = sA * w01 + tA; sB = sB * w23 + tB;
                f32x2 q = sA * r01; q = sB * r23 + q;
                yv[u] = q[0] + q[1];
            }
#pragma unroll
            for (int u = 0; u < 4; ++u) yv[u] = ror_add<0x128>(yv[u]);
#pragma unroll
            for (int u = 0; u < 4; ++u) yv[u] = ror_add<0x124>(yv[u]);
#pragma unroll
            for (int u = 0; u < 4; ++u) yv[u] = ror_add<0x122>(yv[u]);
#pragma unroll
            for (int u = 0; u < 4; ++u) yv[u] = ror_add<0x121>(yv[u]);
            if (kl == 0) *(LAS f32x4*)(yo + rowl * SC + t4) = (f32x4){yv[0], yv[1], yv[2], yv[3]};
        }
        if (c + 1 < NCH) RW_STORE((c + 1) & 1);
        __syncthreads();
    }
    {   const LAS float* ys = yb + ((NCH - 1) & 1) * SC * 32 + (2 * spart) * SC + stk;
        *(unsigned*)(H + ((size_t)b * SEQ + (size_t)(NCH - 1) * SC + stk) * HP + C_RR + hd * 64 + half * 32 + 2 * spart) = pk2(ys[0], ys[SC]); }
#undef RW_LOAD
#undef RW_STORE
}

constexpr int PG = 168;
DI void rwkv_post_item(KA a, const int l, LAS unsigned char* lds, const int tile) {
    const int tid = tid_(), lane = tid & 63, w = tid >> 6, fr = lane & 15, fq = lane >> 4;
    unsigned char* ws = a->ws;
    const bf16* H = (const bf16*)(ws + WS_H);
    LAS bf16* Ag = (LAS bf16*)lds;
    const int t0 = tile * 64;
    const float* mu = a->in[I_MU] + l * 1056;
    __syncthreads();
    for (int idx = tid; idx < 64 * 20; idx += NTHR) { const int tk = idx / 20, c0 = (idx % 20) * 8, t = t0 + tk; const bool first = (t & (SEQ - 1)) == 0;
        const bf16* hr = H + (size_t)t * HP; float cu[8], pv[8], o[8];
        unpack8(*(const v4u*)(hr + C_RGL + c0), cu); if (first) { for (int e = 0; e < 8; ++e) pv[e] = 0.f; } else unpack8(*(const v4u*)(hr - HP + C_RGL + c0), pv);
#pragma unroll
        for (int e = 0; e < 8; ++e) o[e] = sigmoidf_(cu[e] + (pv[e] - cu[e]) * mu[896 + c0 + e]);
        *(LAS v4u*)(Ag + tk * PG + c0) = pack8(o); }
    __syncthreads();
    const int hd = w >> 1, th = w & 1;
    f32x4 accg[4][2];
#pragma unroll
    for (int ct = 0; ct < 4; ++ct) { accg[ct][0] = ZERO4; accg[ct][1] = ZERO4; }
    const bf16* g2T = (const bf16*)(ws + WS_SMALL + l * SMALL_STRIDE + SM_G2T);
#pragma unroll
    for (int ks = 0; ks < 5; ++ks) {
        bf16x8 af[2];
#pragma unroll
        for (int rt = 0; rt < 2; ++rt) af[rt] = *(const LAS bf16x8*)(Ag + (32 * th + 16 * rt + fr) * PG + ks * 32 + fq * 8);
#pragma unroll
        for (int ct = 0; ct < 4; ++ct) { const bf16x8 bg = *(const bf16x8*)(g2T + (size_t)(hd * 64 + ct * 16 + fr) * 192 + ks * 32 + fq * 8);
#pragma unroll
            for (int rt = 0; rt < 2; ++rt) accg[ct][rt] = mma16(bg, af[rt], accg[ct][rt]); }
    }
    const bf16* Rr = (const bf16*)(ws + WS_RR); const bf16* Rk = (const bf16*)(ws + WS_RK); const bf16* Rv = (const bf16*)(ws + WS_RV);
    const float* rkw = a->in[I_RK] + l * 256; const float* lnw = a->in[I_RLNW] + l * 256; const float* lnb = a->in[I_RLNB] + l * 256;
    bf16* act = (bf16*)(ws + WS_ACT);
#pragma unroll
    for (int rt = 0; rt < 2; ++rt) { const int tk = t0 + 32 * th + 16 * rt + fr;
        float y[4][4], sy = 0.f, srk = 0.f;
#pragma unroll
        for (int ct = 0; ct < 4; ++ct) { const int c4 = hd * 64 + ct * 16 + 4 * fq; const size_t ro = (size_t)tk * 256 + c4; const f32x4 rk4 = *(const f32x4*)(rkw + c4);
            const v2u yy = *(const v2u*)(H + (size_t)tk * HP + C_RR + c4), r2 = *(const v2u*)(Rr + ro), k2 = *(const v2u*)(Rk + ro);
            const float y_[4] = {bflo(yy.x), bfhi(yy.x), bflo(yy.y), bfhi(yy.y)}, r_[4] = {bflo(r2.x), bfhi(r2.x), bflo(r2.y), bfhi(r2.y)}, k_[4] = {bflo(k2.x), bfhi(k2.x), bflo(k2.y), bfhi(k2.y)};
#pragma unroll
            for (int j = 0; j < 4; ++j) { y[ct][j] = y_[j]; sy += y_[j]; srk += r_[j] * k_[j] * rk4[j]; } }
        sy += __shfl_xor(sy, 16); sy += __shfl_xor(sy, 32); srk += __shfl_xor(srk, 16); srk += __shfl_xor(srk, 32);
        const float mean = sy * (1.f / 64.f); float q = 0.f;
#pragma unroll
        for (int ct = 0; ct < 4; ++ct)
#pragma unroll
            for (int j = 0; j < 4; ++j) { const float d = y[ct][j] - mean; q += d * d; }
        q += __shfl_xor(q, 16); q += __shfl_xor(q, 32);
        const float rstd = 1.f / sqrtf(q * (1.f / 64.f) + 64e-5f);
#pragma unroll
        for (int ct = 0; ct < 4; ++ct) { const int c4 = hd * 64 + ct * 16 + 4 * fq; const size_t ro = (size_t)tk * 256 + c4; const f32x4 lw = *(const f32x4*)(lnw + c4), lb = *(const f32x4*)(lnb + c4);
            const v2u v2 = *(const v2u*)(Rv + ro); const float v_[4] = {bflo(v2.x), bfhi(v2.x), bflo(v2.y), bfhi(v2.y)}; float o[4];
#pragma unroll
            for (int j = 0; j < 4; ++j) o[j] = ((y[ct][j] - mean) * rstd * lw[j] + lb[j] + srk * v_[j]) * accg[ct][rt][j];
            v2u p; p.x = pk2(o[0], o[1]); p.y = pk2(o[2], o[3]); *(v2u*)(act + (size_t)tk * D + 256 + c4) = p; }
    }
}

DI void gla_item(KA a, const int l, LAS unsigned char* lds, const int item) {
    const int tid = tid_(), lane = tid & 63, w = tid >> 6, fr = lane & 15, fq = lane >> 4;
    const int b = item >> 2, hh = item & 3;
    unsigned char* ws = a->ws;
    const bf16* H = (const bf16*)(ws + WS_H); bf16* act = (bf16*)(ws + WS_ACT);
    LAS float* LA = (LAS float*)lds; LAS float* OUTF = LA + 4096; LAS float* WA2 = OUTF + 4096; LAS float* BA = WA2 + 1024; LAS float* SEG = BA + 64; LAS float* DEC = SEG + 512;
    LAS bf16* Qt = (LAS bf16*)(lds + 40960); LAS bf16* Kt = Qt + 64 * PA; LAS bf16* KhT = Kt + 64 * PA; LAS bf16* VT = KhT + 64 * PA; LAS bf16* Pm = VT + 64 * PA; LAS bf16* ST = Pm + 64 * PA;
    __syncthreads();
    { const float* wa2 = a->in[I_GLA_A2] + (size_t)l * 16 * 256; const float* ba = a->in[I_GLA_BA] + l * 256;
      for (int i = tid; i < 1024; i += NTHR) WA2[i] = wa2[(i >> 6) * 256 + hh * 64 + (i & 63)];
      if (tid < 64) BA[tid] = ba[hh * 64 + tid];
      for (int i = tid; i < 64 * PA / 2; i += NTHR) ((LAS unsigned*)ST)[i] = 0u; }
    const float* lnw = a->in[I_GLA_LNW] + l * 256 + hh * 64; const float* lnb = a->in[I_GLA_LNB] + l * 256 + hh * 64;
    f32x4 S[2] = {ZERO4, ZERO4};
    const int t = tid >> 3, kg = tid & 7, rt = w & 3, cp = (w >> 2) * 2;
    __syncthreads();
    v4u pq, pk_, pv_, pg_, pa0, pa1;
    { const bf16* hr0 = H + ((size_t)b * SEQ + t) * HP; pq = *(const v4u*)(hr0 + C_GQ + hh * 64 + 8 * kg); pk_ = *(const v4u*)(hr0 + C_GK + hh * 64 + 8 * kg); pv_ = *(const v4u*)(hr0 + C_GV + hh * 64 + 8 * kg);
      pg_ = *(const v4u*)(hr0 + C_GG + hh * 64 + 8 * kg); pa0 = *(const v4u*)(hr0 + C_GA); pa1 = *(const v4u*)(hr0 + C_GA + 8); }
    for (int c = 0; c < SEQ / 64; ++c) {
        const size_t tb = (size_t)b * SEQ + (size_t)c * 64;
        float q8[8], k8[8], v8[8];
        const v4u cg_ = pg_;
        {
            float al[16]; { float tmp[8]; unpack8(pa0, tmp); for (int e = 0; e < 8; ++e) al[e] = tmp[e]; unpack8(pa1, tmp); for (int e = 0; e < 8; ++e) al[8 + e] = tmp[e]; }
            unpack8(pq, q8); unpack8(pk_, k8); unpack8(pv_, v8);
            if (c + 1 < SEQ / 64) { const bf16* hn = H + (tb + 64 + t) * HP; pq = *(const v4u*)(hn + C_GQ + hh * 64 + 8 * kg); pk_ = *(const v4u*)(hn + C_GK + hh * 64 + 8 * kg); pv_ = *(const v4u*)(hn + C_GV + hh * 64 + 8 * kg);
                pg_ = *(const v4u*)(hn + C_GG + hh * 64 + 8 * kg); pa0 = *(const v4u*)(hn + C_GA); pa1 = *(const v4u*)(hn + C_GA + 8); }
#pragma unroll
            for (int e = 0; e < 8; ++e) { float z = BA[8 * kg + e];
#pragma unroll
                for (int j = 0; j < 16; ++j) z += al[j] * WA2[j * 64 + 8 * kg + e];
                LA[t * 64 + 8 * kg + e] = (fminf(z, 0.f) - __logf(1.f + __expf(-fabsf(z)))) * (1.f / 16.f); }
        }
        __syncthreads();
        {
            const int k = tid & 63, sg = tid >> 6; float run = 0.f;
#pragma unroll
            for (int i = 0; i < 8; ++i) { run += LA[(8 * sg + i) * 64 + k]; LA[(8 * sg + i) * 64 + k] = run; }
            SEG[sg * 64 + k] = run;
        }
        __syncthreads();
        {
            const int sg = t >> 3; float qo[8], ko[8];
#pragma unroll
            for (int e = 0; e < 8; ++e) { const int k = 8 * kg + e; float pre = 0.f, tot = 0.f;
#pragma unroll
                for (int s2 = 0; s2 < 8; ++s2) { const float sv = SEG[s2 * 64 + k]; tot += sv; pre += (s2 < sg) ? sv : 0.f; }
                const float bv = LA[t * 64 + k] + pre;
                qo[e] = q8[e] * 0.125f * __expf(bv); ko[e] = k8[e] * __expf(-bv);
                KhT[k * PA + t] = (bf16)f2bf(k8[e] * __expf(tot - bv)); VT[k * PA + t] = (bf16)f2bf(v8[e]);
                if (t == 63) DEC[k] = __expf(tot); }
            *(LAS v4u*)(Qt + t * PA + 8 * kg) = pack8(qo); *(LAS v4u*)(Kt + t * PA + 8 * kg) = pack8(ko);
        }
        __syncthreads();
        f32x4 ao[2] = {ZERO4, ZERO4};
        {
#pragma unroll
            for (int ks = 0; ks < 2; ++ks) { const bf16x8 aq = *(const LAS bf16x8*)(Qt + (16 * rt + fr) * PA + ks * 32 + fq * 8);
#pragma unroll
                for (int i = 0; i < 2; ++i) { const bf16x8 bs = *(const LAS bf16x8*)(ST + (16 * (cp + i) + fr) * PA + ks * 32 + fq * 8); ao[i] = mma16(aq, bs, ao[i]); } }
            f32x4 pp[2] = {ZERO4, ZERO4};
#pragma unroll
            for (int ks = 0; ks < 2; ++ks) { const bf16x8 aq = *(const LAS bf16x8*)(Qt + (16 * rt + fr) * PA + ks * 32 + fq * 8);
#pragma unroll
                for (int i = 0; i < 2; ++i) { const bf16x8 bk = *(const LAS bf16x8*)(Kt + (16 * (cp + i) + fr) * PA + ks * 32 + fq * 8); pp[i] = mma16(aq, bk, pp[i]); } }
#pragma unroll
            for (int i = 0; i < 2; ++i)
#pragma unroll
                for (int j = 0; j < 4; ++j) { const int tr = 16 * rt + 4 * fq + j, sc = 16 * (cp + i) + fr; Pm[tr * PA + sc] = (bf16)f2bf(sc <= tr ? pp[i][j] : 0.f); }
        }
        __syncthreads();
        {
#pragma unroll
            for (int ks = 0; ks < 2; ++ks) { const bf16x8 ap = *(const LAS bf16x8*)(Pm + (16 * rt + fr) * PA + ks * 32 + fq * 8); const bf16x8 ak = *(const LAS bf16x8*)(KhT + (16 * rt + fr) * PA + ks * 32 + fq * 8);
                f32x4 u[2];
#pragma unroll
                for (int i = 0; i < 2; ++i) { const bf16x8 bv = *(const LAS bf16x8*)(VT + (16 * (cp + i) + fr) * PA + ks * 32 + fq * 8); ao[i] = mma16(ap, bv, ao[i]);
                    if (ks == 0) { f32x4 sd; for (int j = 0; j < 4; ++j) sd[j] = S[i][j] * DEC[16 * rt + 4 * fq + j]; S[i] = sd; }
                    S[i] = mma16(ak, bv, S[i]); }
            }
#pragma unroll
            for (int i = 0; i < 2; ++i)
#pragma unroll
                for (int j = 0; j < 4; ++j) OUTF[(16 * rt + 4 * fq + j) * 64 + 16 * (cp + i) + fr] = ao[i][j];
        }
        __syncthreads();
        {
#pragma unroll
            for (int i = 0; i < 2; ++i) { v2u p; p.x = pk2(S[i][0], S[i][1]); p.y = pk2(S[i][2], S[i][3]); *(LAS v2u*)(ST + (16 * (cp + i) + fr) * PA + 16 * rt + 4 * fq) = p; }
            float x[8], sm = 0.f;
#pragma unroll
            for (int e = 0; e < 8; ++e) { x[e] = OUTF[t * 64 + 8 * kg + e]; sm += x[e]; }
            sm += __shfl_xor(sm, 1); sm += __shfl_xor(sm, 2); sm += __shfl_xor(sm, 4);
            const float mean = sm * (1.f / 64.f); float qv = 0.f;
#pragma unroll
            for (int e = 0; e < 8; ++e) { x[e] -= mean; qv += x[e] * x[e]; }
            qv += __shfl_xor(qv, 1); qv += __shfl_xor(qv, 2); qv += __shfl_xor(qv, 4);
            const float rstd = 1.f / sqrtf(qv * (1.f / 64.f) + LN_EPS);
            float g8[8], o[8]; unpack8(cg_, g8);
#pragma unroll
            for (int e = 0; e < 8; ++e) { const float yv = x[e] * rstd * lnw[8 * kg + e] + lnb[8 * kg + e]; o[e] = yv * g8[e] * sigmoidf_(g8[e]); }
            *(v4u*)(act + (tb + t) * D + hh * 64 + 8 * kg) = pack8(o);
        }
    }
}
template <int CTRL> DI float dppx(float x) { return __builtin_bit_cast(float, __builtin_amdgcn_update_dpp(0, __builtin_bit_cast(int, x), CTRL, 0xF, 0xF, true)); }
DI void rwkv_scan2_item(KA a, LAS unsigned char* lds, const int item) {
    const int tid = tid_(), lane = tid & 63, w = tid >> 6, kl = lane & 15, row0 = w * 8 + 2 * (lane >> 4);
    const int half = item & 1, bh = item >> 1, hd = bh & 3, b = bh >> 2;
    unsigned char* ws = a->ws;
    const float* Rw = (const float*)(ws + WS_RW); const bf16* Rr = (const bf16*)(ws + WS_RR); const bf16* Rk = (const bf16*)(ws + WS_RK); const bf16* Rv = (const bf16*)(ws + WS_RV); const bf16* Ra = (const bf16*)(ws + WS_RA); const bf16* Rb = (const bf16*)(ws + WS_RB);
    bf16* H = (bf16*)(ws + WS_H);
    LAS float* sb = (LAS float*)lds; LAS float* yb = sb + 2 * SBUF_F;
    const int stk = tid >> 4, spart = tid & 15;
    const size_t gbase = (size_t)b * SEQ * 256 + hd * 64;
    f32x4 gw; v2u gr, gk, ga, gb; unsigned gv;
#define RW_LOAD(c) do { const size_t o_ = gbase + (size_t)((c) * SC + stk) * 256 + 4 * spart; gw = *(const f32x4*)(Rw + o_); gr = *(const v2u*)(Rr + o_); gk = *(const v2u*)(Rk + o_); ga = *(const v2u*)(Ra + o_); gb = *(const v2u*)(Rb + o_); \
        gv = *(const unsigned*)(Rv + gbase + (size_t)((c) * SC + stk) * 256 + half * 32 + 2 * spart); } while (0)
#define BF4(u_) ((f32x4){bflo((u_).x), bfhi((u_).x), bflo((u_).y), bfhi((u_).y)})
#define RW_STORE(bufi) do { LAS float* d_ = sb + (bufi) * SBUF_F; const int o_ = stk * 64 + 4 * spart; \
        *(LAS f32x4*)(d_ + o_) = BF4(gr); *(LAS f32x4*)(d_ + SC * 64 + o_) = gw; *(LAS f32x4*)(d_ + 2 * SC * 64 + o_) = BF4(gk); *(LAS f32x4*)(d_ + 3 * SC * 64 + o_) = BF4(ga); \
        *(LAS f32x4*)(d_ + 4 * SC * 64 + o_) = BF4(gb); *(LAS f32x2*)(d_ + 5 * SC * 64 + stk * 32 + 2 * spart) = (f32x2){bflo(gv), bfhi(gv)}; } while (0)
#define FLUSH(c_) do { const LAS float* ys = yb + ((c_) & 1) * SC * 32 + (2 * spart) * SC + stk; \
        *(unsigned*)(H + ((size_t)b * SEQ + (size_t)(c_) * SC + stk) * HP + C_RR + hd * 64 + half * 32 + 2 * spart) = pk2(ys[0], ys[SC]); } while (0)
    __syncthreads();
    RW_LOAD(0); RW_STORE(0);
    __syncthreads();
    f32x2 s00 = {0.f, 0.f}, s01 = {0.f, 0.f}, s10 = {0.f, 0.f}, s11 = {0.f, 0.f};
    constexpr int NCH = SEQ / SC;
    for (int c = 0; c < NCH; ++c) {
        if (c + 1 < NCH) RW_LOAD(c + 1);
        if (c > 0) FLUSH(c - 1);
        if (w < 4) {
            const LAS float* d_ = sb + (c & 1) * SBUF_F; LAS float* yo = yb + (c & 1) * SC * 32;
            for (int t4 = 0; t4 < SC; t4 += 4) {
                f32x4 R4[4], W4[4], K4[4], A4[4], B4[4]; f32x2 V2[4]; float y0[4], y1[4];
#pragma unroll
                for (int u = 0; u < 4; ++u) { const int o_ = (t4 + u) * 64 + 4 * kl;
                    R4[u] = *(const LAS f32x4*)(d_ + o_); W4[u] = *(const LAS f32x4*)(d_ + SC * 64 + o_); K4[u] = *(const LAS f32x4*)(d_ + 2 * SC * 64 + o_);
                    A4[u] = *(const LAS f32x4*)(d_ + 3 * SC * 64 + o_); B4[u] = *(const LAS f32x4*)(d_ + 4 * SC * 64 + o_); V2[u] = *(const LAS f32x2*)(d_ + 5 * SC * 64 + (t4 + u) * 32 + row0); }
#pragma unroll
                for (int u = 0; u < 4; ++u) {
                    const f32x2 a01 = {A4[u][0], A4[u][1]}, a23 = {A4[u][2], A4[u][3]}, b01 = {B4[u][0], B4[u][1]}, b23 = {B4[u][2], B4[u][3]};
                    const f32x2 k01 = {K4[u][0], K4[u][1]}, k23 = {K4[u][2], K4[u][3]}, w01 = {W4[u][0], W4[u][1]}, w23 = {W4[u][2], W4[u][3]}, r01 = {R4[u][0], R4[u][1]}, r23 = {R4[u][2], R4[u][3]};
                    f32x2 p0 = s00 * a01; p0 = s01 * a23 + p0; f32x2 p1 = s10 * a01; p1 = s11 * a23 + p1;
                    float d0 = p0[0] + p0[1], d1 = p1[0] + p1[1];
                    d0 = ror_add<0x128>(d0); d1 = ror_add<0x128>(d1); d0 = ror_add<0x124>(d0); d1 = ror_add<0x124>(d1); d0 = ror_add<0x122>(d0); d1 = ror_add<0x122>(d1); d0 = ror_add<0x121>(d0); d1 = ror_add<0x121>(d1);
                    const float v0 = V2[u][0], v1 = V2[u][1];
                    s00 = s00 * w01 + (k01 * v0 + b01 * d0); s01 = s01 * w23 + (k23 * v0 + b23 * d0);
                    s10 = s10 * w01 + (k01 * v1 + b01 * d1); s11 = s11 * w23 + (k23 * v1 + b23 * d1);
                    f32x2 q0 = s00 * r01; q0 = s01 * r23 + q0; f32x2 q1 = s10 * r01; q1 = s11 * r23 + q1;
                    y0[u] = q0[0] + q0[1]; y1[u] = q1[0] + q1[1];
                }
                {
                    const bool b3 = (kl & 8) != 0, b2 = (kl & 4) != 0, b1 = (kl & 2) != 0;
                    float w4[4], x2[2];
#pragma unroll
                    for (int u = 0; u < 4; ++u) { const float keep = b3 ? y1[u] : y0[u], send = b3 ? y0[u] : y1[u]; w4[u] = keep + dppx<0x140>(send); }
#pragma unroll
                    for (int u = 0; u < 2; ++u) { const float keep = b2 ? w4[2 + u] : w4[u], send = b2 ? w4[u] : w4[2 + u]; x2[u] = keep + dppx<0x141>(send); }
                    const float keep1 = b1 ? x2[1] : x2[0], send1 = b1 ? x2[0] : x2[1];
                    float z = keep1 + dppx<0x1B>(send1);
                    z = z + dppx<0xB1>(z);
                    if ((kl & 1) == 0) yo[(row0 + (b3 ? 1 : 0)) * SC + t4 + (b2 ? 2 : 0) + (b1 ? 1 : 0)] = z;
                }
            }
        }
        if (c + 1 < NCH) RW_STORE((c + 1) & 1);
        __syncthreads();
    }
    FLUSH(NCH - 1);
#undef RW_LOAD
#undef RW_STORE
#undef BF4
#undef FLUSH
}
constexpr float QSCALE = 0.125f * 1.4426950408889634f;
DI void nsa_rope(KA a) {
    const int tid = tid_();
    unsigned char* ws = a->ws; bf16* H = (bf16*)(ws + WS_H); const float* ct = (const float*)(ws + WS_COS); const float* st = (const float*)(ws + WS_SIN);
    const int ustride = gridDim.x * NTHR;
    for (int u0 = blockIdx.x * NTHR + tid; u0 < T * 48; u0 += 2 * ustride) {
        v4u a1[2], a2[2]; f32x4 cc[2][2], sn[2][2]; bf16* pp[2]; float scs[2]; bool ok[2];
#pragma unroll
        for (int q = 0; q < 2; ++q) { const int u = u0 + q * ustride; ok[q] = u < T * 48; if (ok[q]) { const int t = u / 48, rem = u - t * 48, hd = rem >> 2, m = rem & 3, pos = t & (SEQ - 1);
            const int col0 = hd < 8 ? C_NQ + hd * 64 : (hd < 10 ? C_NKS + (hd - 8) * 64 : C_NKW + (hd - 10) * 64); scs[q] = hd < 8 ? QSCALE : 1.f;
            pp[q] = H + (size_t)t * HP + col0 + 8 * m; a1[q] = *(const v4u*)pp[q]; a2[q] = *(const v4u*)(pp[q] + 32);
            cc[q][0] = *(const f32x4*)(ct + pos * 32 + 8 * m); cc[q][1] = *(const f32x4*)(ct + pos * 32 + 8 * m + 4); sn[q][0] = *(const f32x4*)(st + pos * 32 + 8 * m); sn[q][1] = *(const f32x4*)(st + pos * 32 + 8 * m + 4); } }
#pragma unroll
        for (int q = 0; q < 2; ++q) if (ok[q]) { float x1[8], x2[8], o1[8], o2[8]; unpack8(a1[q], x1); unpack8(a2[q], x2);
#pragma unroll
            for (int e = 0; e < 8; ++e) { const float c = cc[q][e >> 2][e & 3], s = sn[q][e >> 2][e & 3]; o1[e] = (x1[e] * c - x2[e] * s) * scs[q]; o2[e] = (x1[e] * s + x2[e] * c) * scs[q]; }
            *(v4u*)pp[q] = pack8(o1); *(v4u*)(pp[q] + 32) = pack8(o2); }
    }
}
constexpr int PH = 264;
DI float gelu_tanh(float x) { return 0.5f * x * (1.f + fast_tanh(0.7978845608028654f * (x + 0.044715f * x * x * x))); }
DI void nsa_compress_item(KA a, const int l, LAS unsigned char* lds, const int it) {
    const int tid = tid_(), lane = tid & 63, w = tid >> 6, fr = lane & 15, fq = lane >> 4;
    const int kv = it & 1, ctile = (it >> 1) & 1, bg = it >> 2, b = bg >> 1, g = bg & 1;
    unsigned char* ws = a->ws; const bf16* H = (const bf16*)(ws + WS_H); const float* ctab = (const float*)(ws + WS_COS); const float* stab = (const float*)(ws + WS_SIN);
    LAS bf16* At = (LAS bf16*)lds; LAS bf16* Hd = At + 64 * PA;
    const bf16* W1T = (const bf16*)(ws + WS_WC1 + (size_t)(l * 2 + kv) * MiB);
    const bf16* W2T = (const bf16*)(ws + WS_SMALL + l * SMALL_STRIDE + (kv ? SM_WV2T : SM_WK2T));
    const float* pos = a->in[kv ? I_POSV : I_POSK] + l * 32 * 64;
    const int colbase = (kv ? C_NVC : C_NKC) + g * 64;
    f32x4 acc[4][2];
#pragma unroll
    for (int rt = 0; rt < 4; ++rt) { acc[rt][0] = ZERO4; acc[rt][1] = ZERO4; }
    const bool stager = (tid & 7) < 4; const int sc_ = tid >> 3, sm_ = tid & 3, scg = 64 * ctile + sc_; const bool svalid = scg < 127;
    v4u xr1 = {0u, 0u, 0u, 0u}, xr2 = {0u, 0u, 0u, 0u}; f32x4 cs[2], sn[2], ps1[2], ps2[2]; bf16x8 bcur[2][2], bnxt[2][2];
#define CMP_LOADA(ll_) do { if (stager) { const int s_ = 16 * scg + (ll_); if (svalid) { const bf16* hp_ = H + ((size_t)b * SEQ + s_) * HP + colbase + 8 * sm_; xr1 = *(const v4u*)hp_; xr2 = *(const v4u*)(hp_ + 32); \
            if (kv == 0) { cs[0] = *(const f32x4*)(ctab + s_ * 32 + 8 * sm_); cs[1] = *(const f32x4*)(ctab + s_ * 32 + 8 * sm_ + 4); sn[0] = *(const f32x4*)(stab + s_ * 32 + 8 * sm_); sn[1] = *(const f32x4*)(stab + s_ * 32 + 8 * sm_ + 4); } } \
            ps1[0] = *(const f32x4*)(pos + (ll_) * 64 + 8 * sm_); ps1[1] = *(const f32x4*)(pos + (ll_) * 64 + 8 * sm_ + 4); ps2[0] = *(const f32x4*)(pos + (ll_) * 64 + 32 + 8 * sm_); ps2[1] = *(const f32x4*)(pos + (ll_) * 64 + 32 + 8 * sm_ + 4); } } while (0)
#define CMP_LOADB(dst, ll_) do { _Pragma("unroll") for (int ks = 0; ks < 2; ++ks) _Pragma("unroll") for (int ct = 0; ct < 2; ++ct) dst[ks][ct] = *(const bf16x8*)(W1T + (size_t)(32 * w + 16 * ct + fr) * 2048 + (ll_) * 64 + ks * 32 + fq * 8); } while (0)
    CMP_LOADA(0); CMP_LOADB(bcur, 0);
    for (int ll = 0; ll < 32; ++ll) {
        __syncthreads();
        if (stager) { float x1[8], x2[8], o1[8], o2[8]; unpack8(xr1, x1); unpack8(xr2, x2);
#pragma unroll
            for (int e = 0; e < 8; ++e) { float y1 = svalid ? x1[e] : 0.f, y2 = svalid ? x2[e] : 0.f;
                if (kv == 0 && svalid) { const float cc = cs[e >> 2][e & 3], ss = sn[e >> 2][e & 3]; y1 = x1[e] * cc - x2[e] * ss; y2 = x1[e] * ss + x2[e] * cc; }
                o1[e] = y1 + ps1[e >> 2][e & 3]; o2[e] = y2 + ps2[e >> 2][e & 3]; }
            *(LAS v4u*)(At + sc_ * PA + 8 * sm_) = pack8(o1); *(LAS v4u*)(At + sc_ * PA + 32 + 8 * sm_) = pack8(o2); }
        __syncthreads();
        if (ll + 1 < 32) { CMP_LOADA(ll + 1); CMP_LOADB(bnxt, ll + 1); }
#pragma unroll
        for (int ks = 0; ks < 2; ++ks) {
#pragma unroll
            for (int rt = 0; rt < 4; ++rt) { const bf16x8 af = *(const LAS bf16x8*)(At + (16 * rt + fr) * PA + ks * 32 + fq * 8); acc[rt][0] = mma16(af, bcur[ks][0], acc[rt][0]); acc[rt][1] = mma16(af, bcur[ks][1], acc[rt][1]); } }
#pragma unroll
        for (int ks = 0; ks < 2; ++ks) { bcur[ks][0] = bnxt[ks][0]; bcur[ks][1] = bnxt[ks][1]; }
    }
#undef CMP_LOADA
#undef CMP_LOADB
    __syncthreads();
#pragma unroll
    for (int rt = 0; rt < 4; ++rt)
#pragma unroll
        for (int ct = 0; ct < 2; ++ct)
#pragma unroll
            for (int j = 0; j < 4; ++j) Hd[(16 * rt + 4 * fq + j) * PH + 32 * w + 16 * ct + fr] = (bf16)f2bf(gelu_tanh(acc[rt][ct][j]));
    __syncthreads();
    const int rt2 = w & 3, ct2 = (w >> 2) * 2;
    f32x4 o2[2] = {ZERO4, ZERO4};
#pragma unroll
    for (int ks = 0; ks < 8; ++ks) { const bf16x8 af = *(const LAS bf16x8*)(Hd + (16 * rt2 + fr) * PH + ks * 32 + fq * 8);
#pragma unroll
        for (int i = 0; i < 2; ++i) { const bf16x8 bfr = *(const bf16x8*)(W2T + (size_t)(16 * (ct2 + i) + fr) * 256 + ks * 32 + fq * 8); o2[i] = mma16(af, bfr, o2[i]); } }
    bf16* dst = (bf16*)(ws + (kv ? WS_VCMP : WS_KCMP)) + (size_t)bg * 128 * 64;
#pragma unroll
    for (int i = 0; i < 2; ++i)
#pragma unroll
        for (int j = 0; j < 4; ++j) { const int cg = 64 * ctile + 16 * rt2 + 4 * fq + j; dst[cg * 64 + 16 * (ct2 + i) + fr] = (bf16)f2bf(cg < 127 ? o2[i][j] : 0.f); }
}


constexpr int PV = 136;
constexpr int NSA_KT = 0, NSA_VT = 18432, NSA_KT1 = 36864, NSA_VT1 = 46080, NSA_IMP = 65536, NSA_IMPT = 98304, NSA_SELM = 106496, NSA_LIST = 106752, NSA_NLIST = 106944, NSA_UN = 106960, NSA_ITEM = 107008;
DI int crow(int i, int hf) { return (i & 3) + 8 * (i >> 2) + 4 * hf; }
DI bf16x8 packp(const f32x16& x, const int h8) { v4u p; p.x = pk2(x[h8 + 0], x[h8 + 1]); p.y = pk2(x[h8 + 2], x[h8 + 3]); p.z = pk2(x[h8 + 4], x[h8 + 5]); p.w = pk2(x[h8 + 6], x[h8 + 7]); return __builtin_bit_cast(bf16x8, p); }
DI int vpos(const int key) { return (key & ~15) + (((key >> 3) & 1) << 2) + (((key >> 2) & 1) << 3) + (key & 3); }
DI bf16x8 vfrag(const LAS bf16* VT, const int row, const int sp, const int hf) { return *(const LAS bf16x8*)(VT + row * PV + 16 * sp + 8 * hf); }
#define ZERO16 ((f32x16){0.f,0.f,0.f,0.f,0.f,0.f,0.f,0.f,0.f,0.f,0.f,0.f,0.f,0.f,0.f,0.f})
DI void nsa_item(KA a, LAS unsigned char* lds, const int it) {
    const int tid = tid_(), lane = tid & 63, w = tid >> 6, r = lane & 31, hf = lane >> 5;
    const int qb = 31 - (it >> 5), bg = it & 31, b = bg >> 1, g = bg & 1, hh = w >> 1, head = g * 4 + hh, tql = 32 * (w & 1) + r;
    unsigned char* ws = a->ws; const bf16* H = (const bf16*)(ws + WS_H); bf16* act = (bf16*)(ws + WS_ACT);
    const size_t tokrow = (size_t)b * SEQ + 64 * qb + tql;
    LAS bf16* Kt = (LAS bf16*)(lds + NSA_KT); LAS bf16* VT = (LAS bf16*)(lds + NSA_VT); LAS float* IMP = (LAS float*)(lds + NSA_IMP); LAS float* IMPT = (LAS float*)(lds + NSA_IMPT);
    LAS unsigned* SELM = (LAS unsigned*)(lds + NSA_SELM); LAS int* LIST = (LAS int*)(lds + NSA_LIST); LAS int* NLIST = (LAS int*)(lds + NSA_NLIST);
    bf16x8 bq[4];
#pragma unroll
    for (int s = 0; s < 4; ++s) bq[s] = *(const bf16x8*)(H + tokrow * HP + C_NQ + head * 64 + 16 * s + 8 * hf);
    const float g0 = sigmoidf_(ldbf(H + tokrow * HP + C_NG + head * 3 + 0)), g1 = sigmoidf_(ldbf(H + tokrow * HP + C_NG + head * 3 + 1)), g2 = sigmoidf_(ldbf(H + tokrow * HP + C_NG + head * 3 + 2));
    { const bf16* kc = (const bf16*)(ws + WS_KCMP) + (size_t)bg * 128 * 64; const bf16* vc = (const bf16*)(ws + WS_VCMP) + (size_t)bg * 128 * 64;
#pragma unroll
      for (int i = 0; i < 2; ++i) { const int idx = tid + NTHR * i; const int c = idx >> 3, ch = idx & 7; *(LAS v4u*)(Kt + c * PA + 8 * ch) = *(const v4u*)(kc + c * 64 + 8 * ch);
          const int dg = idx & 15, kp = idx >> 4; const v2u v0 = *(const v2u*)(vc + (2 * kp) * 64 + 4 * dg), v1 = *(const v2u*)(vc + (2 * kp + 1) * 64 + 4 * dg);
          LAS unsigned* d0 = (LAS unsigned*)(VT + (4 * dg) * PV + vpos(2 * kp));
          d0[0] = (v0.x & 0xffffu) | (v1.x << 16); d0[PV / 2] = (v0.x >> 16) | (v1.x & 0xffff0000u); d0[PV] = (v0.y & 0xffffu) | (v1.y << 16); d0[3 * PV / 2] = (v0.y >> 16) | (v1.y & 0xffff0000u); } }
    __syncthreads();
    f32x16 of[2] = {ZERO16, ZERO16};
    {
        f32x16 st[4] = {ZERO16, ZERO16, ZERO16, ZERO16};
#pragma unroll
        for (int k4 = 0; k4 < 4; ++k4)
#pragma unroll
            for (int s = 0; s < 4; ++s) { const bf16x8 af = *(const LAS bf16x8*)(Kt + (32 * k4 + r) * PA + 16 * s + 8 * hf); st[k4] = mma32(af, bq[s], st[k4]); }
        const int tq = 64 * qb + tql; float mx = -INFINITY;
#pragma unroll
        for (int k4 = 0; k4 < 4; ++k4)
#pragma unroll
            for (int i = 0; i < 16; ++i) { const int c = 32 * k4 + crow(i, hf); const bool ok = (16 * c + 31 <= tq); st[k4][i] = ok ? st[k4][i] : -INFINITY; mx = fmaxf(mx, st[k4][i]); }
        mx = fmaxf(mx, __shfl_xor(mx, 32)); const float mref = (mx == -INFINITY) ? 0.f : mx; float ls = 0.f;
#pragma unroll
        for (int k4 = 0; k4 < 4; ++k4)
#pragma unroll
            for (int i = 0; i < 16; ++i) { const float p = __builtin_amdgcn_exp2f(st[k4][i] - mref); st[k4][i] = p; ls += p; }
        ls += __shfl_xor(ls, 32); const float inv = ls > 0.f ? 1.f / ls : 0.f;
#pragma unroll
        for (int k4 = 0; k4 < 4; ++k4) st[k4] = st[k4] * inv;
        f32x16 ot[2] = {ZERO16, ZERO16};
#pragma unroll
        for (int sp = 0; sp < 8; ++sp) { const bf16x8 pf = packp(st[sp >> 1], 8 * (sp & 1));
#pragma unroll
            for (int dh = 0; dh < 2; ++dh) ot[dh] = mma32(vfrag(VT, 32 * dh + r, sp, hf), pf, ot[dh]); }
        of[0] = ot[0] * g0; of[1] = ot[1] * g0;
        if (qb >= 16) {
        float A16[16], B16[16];
#pragma unroll
        for (int k4 = 0; k4 < 4; ++k4)
#pragma unroll
            for (int q4 = 0; q4 < 4; ++q4) { const float p0 = st[k4][4 * q4], p1 = st[k4][4 * q4 + 1], p2 = st[k4][4 * q4 + 2], p3 = st[k4][4 * q4 + 3]; A16[4 * k4 + q4] = 2.f * (p0 + p1 + p2) + p3; B16[4 * k4 + q4] = p3; }
        float rc[16];
#pragma unroll
        for (int gq = 0; gq < 16; ++gq) rc[gq] = __shfl_xor(B16[gq], 32);
#pragma unroll
        for (int gq = 0; gq < 16; ++gq) { const float prevb = hf ? rc[gq] : (gq > 0 ? rc[gq > 0 ? gq - 1 : 0] : 0.f); IMP[(hh * 64 + tql) * 32 + 2 * gq + hf] = A16[gq] + prevb; }
        }
    }
    if (qb >= 16) {
    __syncthreads();
    { const int tok = tid >> 3, j0 = 4 * (tid & 7);
#pragma unroll
      for (int e = 0; e < 4; ++e) IMPT[tok * 32 + j0 + e] = (IMP[(0 * 64 + tok) * 32 + j0 + e] + IMP[(1 * 64 + tok) * 32 + j0 + e]) + (IMP[(2 * 64 + tok) * 32 + j0 + e] + IMP[(3 * 64 + tok) * 32 + j0 + e]); }
    }
    __syncthreads();
    { const int tok = tid >> 3, j0 = 4 * (tid & 7); unsigned bits = 0u;
      if (qb < 16) bits = (1u << (qb + 1)) - 1u;
      else { float iv[32];
#pragma unroll
          for (int q = 0; q < 8; ++q) { const f32x4 t4 = *(const LAS f32x4*)(IMPT + tok * 32 + 4 * q); iv[4 * q] = t4[0]; iv[4 * q + 1] = t4[1]; iv[4 * q + 2] = t4[2]; iv[4 * q + 3] = t4[3]; }
#pragma unroll
          for (int e = 0; e < 4; ++e) { const int j = j0 + e; const float v = IMPT[tok * 32 + j]; int rank = 0;
#pragma unroll
              for (int jp = 1; jp < 32; ++jp) rank += (jp <= qb - 2 && (iv[jp] > v || (iv[jp] == v && jp < j))) ? 1 : 0;
              if (j >= 1 && j <= qb - 2 && rank < 13) bits |= 1u << j; }
          bits |= __shfl_xor(bits, 1); bits |= __shfl_xor(bits, 2); bits |= __shfl_xor(bits, 4);
          bits |= 1u | (1u << qb) | (1u << (qb - 1)); }
      if ((tid & 7) == 0) SELM[tok] = bits;
      unsigned un = bits; un |= __shfl_xor(un, 8); un |= __shfl_xor(un, 16); un |= __shfl_xor(un, 32);
      if (lane == 0) ((LAS unsigned*)(lds + NSA_UN))[w] = un; }
    __syncthreads();
    {
        unsigned un = 0u;
#pragma unroll
        for (int i = 0; i < 8; ++i) un |= ((LAS unsigned*)(lds + NSA_UN))[i];
        const int nslc = __popc(un), w0 = qb > 8 ? qb - 8 : 0, nwin = qb - w0 + 1;
        if (tid < 32) { if ((un >> tid) & 1u) LIST[__popc(un & ((1u << tid) - 1u))] = tid; }
        else if (tid < 32 + nwin) LIST[nslc + (tid - 32)] = 256 + w0 + (tid - 32);
        if (tid == 0) *NLIST = nslc + nwin; }
    __syncthreads();
    const unsigned mysel = SELM[tql]; const int n = *NLIST;
    v4u kreg; v2u vr0, vr1;
    const int skey = tid >> 3, sch = tid & 7, sdg = tid & 15, skp = tid >> 4;
#define NSA_LOAD(desc) do { const int ty_ = (desc) >> 8, j_ = (desc) & 255; const size_t row_ = (size_t)b * SEQ + 64 * j_; const int kc_ = (ty_ ? C_NKW : C_NKS) + g * 64, vc_ = (ty_ ? C_NVW : C_NVS) + g * 64; \
        kreg = *(const v4u*)(H + (row_ + skey) * HP + kc_ + 8 * sch); vr0 = *(const v2u*)(H + (row_ + 2 * skp) * HP + vc_ + 4 * sdg); vr1 = *(const v2u*)(H + (row_ + 2 * skp + 1) * HP + vc_ + 4 * sdg); } while (0)
#define NSA_STORE(Kb, Vb) do { *(LAS v4u*)((Kb) + skey * PA + 8 * sch) = kreg; LAS unsigned* d0_ = (LAS unsigned*)((Vb) + (4 * sdg) * PV + vpos(2 * skp)); \
        d0_[0] = (vr0.x & 0xffffu) | (vr1.x << 16); d0_[PV / 2] = (vr0.x >> 16) | (vr1.x & 0xffff0000u); d0_[PV] = (vr0.y & 0xffffu) | (vr1.y << 16); d0_[3 * PV / 2] = (vr0.y >> 16) | (vr1.y & 0xffff0000u); } while (0)
    LAS bf16* Kt1 = (LAS bf16*)(lds + NSA_KT1); LAS bf16* VT1 = (LAS bf16*)(lds + NSA_VT1);
    NSA_LOAD(LIST[0]); NSA_STORE(Kt, VT);
    NSA_LOAD(LIST[1]);
    __syncthreads();
    float m_ref = 0.f, l_run = 0.f; f32x16 ot[2] = {ZERO16, ZERO16}; int curtype = 0;
    for (int i = 0; i < n; ++i) {
        const int desc = LIST[i]; const int ty = desc >> 8, j = desc & 255;
        const LAS bf16* Kc = (i & 1) ? Kt1 : Kt; const LAS bf16* Vc = (i & 1) ? VT1 : VT;
        if (ty != curtype) { const float lt = l_run + __shfl_xor(l_run, 32); const float sc = g1 / lt; of[0] += ot[0] * sc; of[1] += ot[1] * sc; ot[0] = ZERO16; ot[1] = ZERO16; m_ref = 0.f; l_run = 0.f; curtype = ty; }
        const bool rowoff = (ty == 0) && (((mysel >> j) & 1u) == 0u);
        const int mode = (j == qb) ? 1 : ((ty == 1 && j == qb - 8) ? 2 : 0);
        const float init = rowoff ? -INFINITY : -m_ref;
        f32x16 st[2];
#pragma unroll
        for (int i2 = 0; i2 < 16; ++i2) { st[0][i2] = init; st[1][i2] = init; }
#pragma unroll
        for (int kt = 0; kt < 2; ++kt)
#pragma unroll
            for (int s = 0; s < 4; ++s) { const bf16x8 af = *(const LAS bf16x8*)(Kc + (32 * kt + r) * PA + 16 * s + 8 * hf); st[kt] = mma32(af, bq[s], st[kt]); }
        if (mode != 0) {
#pragma unroll
            for (int kt = 0; kt < 2; ++kt)
#pragma unroll
                for (int i2 = 0; i2 < 16; ++i2) { const int kl = 32 * kt + crow(i2, hf); const bool bad = rowoff || (mode == 1 && kl > tql) || (mode == 2 && kl <= tql); st[kt][i2] = bad ? -INFINITY : st[kt][i2]; }
        }
        float mx = -INFINITY;
#pragma unroll
        for (int kt = 0; kt < 2; ++kt)
#pragma unroll
            for (int i2 = 0; i2 < 16; ++i2) mx = fmaxf(mx, st[kt][i2]);
        mx = fmaxf(mx, __shfl_xor(mx, 32));
        const bool drift = (fabsf(mx) > 24.f) && (mx > -INFINITY);
        if (__any(drift)) {
            const float d = drift ? mx : 0.f, scl = __builtin_amdgcn_exp2f(-d); m_ref += d; l_run *= scl; ot[0] = ot[0] * scl; ot[1] = ot[1] * scl;
#pragma unroll
            for (int kt = 0; kt < 2; ++kt)
#pragma unroll
                for (int i2 = 0; i2 < 16; ++i2) st[kt][i2] -= d;
        }
        f32x2 ls2 = {0.f, 0.f};
#pragma unroll
        for (int kt = 0; kt < 2; ++kt)
#pragma unroll
            for (int i2 = 0; i2 < 16; i2 += 2) { const float p0 = __builtin_amdgcn_exp2f(st[kt][i2]), p1 = __builtin_amdgcn_exp2f(st[kt][i2 + 1]); st[kt][i2] = p0; st[kt][i2 + 1] = p1; ls2 += (f32x2){p0, p1}; }
        l_run += ls2[0] + ls2[1];
#pragma unroll
        for (int sp = 0; sp < 4; ++sp) { const bf16x8 pf = packp(st[sp >> 1], 8 * (sp & 1));
#pragma unroll
            for (int dh = 0; dh < 2; ++dh) ot[dh] = mma32(vfrag(Vc, 32 * dh + r, sp, hf), pf, ot[dh]); }
        if (i + 1 < n) { if (i & 1) NSA_STORE(Kt, VT); else NSA_STORE(Kt1, VT1); if (i + 2 < n) NSA_LOAD(LIST[i + 2]); }
        __syncthreads();
    }
    { const float lt = l_run + __shfl_xor(l_run, 32); const float sc = g2 / lt; of[0] += ot[0] * sc; of[1] += ot[1] * sc; }
#undef NSA_LOAD
#undef NSA_STORE
#pragma unroll
    for (int dh = 0; dh < 2; ++dh)
#pragma unroll
        for (int q4 = 0; q4 < 4; ++q4) { v2u p; p.x = pk2(of[dh][4 * q4], of[dh][4 * q4 + 1]); p.y = pk2(of[dh][4 * q4 + 2], of[dh][4 * q4 + 3]);
            *(v2u*)(act + tokrow * D + 512 + head * 64 + 32 * dh + 8 * q4 + 4 * hf) = p; }
}
DI void nsa_main(KA a, const int l, LAS unsigned char* lds, const int rep = 0) {
    unsigned* ctr = (unsigned*)(a->ws + WS_CTL) + 64 * (l + 2 * rep);
    for (;;) {
        __syncthreads();
        if (tid_() == 0) *(LAS int*)(lds + NSA_ITEM) = (int)atomicAdd(ctr, 1u);
        __syncthreads();
        const int it = *(LAS int*)(lds + NSA_ITEM);
        if (it >= 1024) break;
        nsa_item(a, lds, it);
    }
}
#ifndef REP_MAIN
#define REP_MAIN 1
#endif
#ifndef REP_PREP
#define REP_PREP 1
#endif
#ifndef EN_PREP
#define EN_PREP 1
#endif
#ifndef EN_GLA
#define EN_GLA 1
#endif
#ifndef EN_SCAN
#define EN_SCAN 1
#endif
#ifndef EN_POST
#define EN_POST 1
#endif
DI void prep_phase(KA a, const int l, LAS unsigned char* lds) {
    nsa_rope(a);
    for (int rep = 0; rep < REP_PREP; ++rep) {
        unsigned* ctr = (unsigned*)(a->ws + WS_CTL) + 64 * (4 + l + 2 * rep);
        for (;;) {
            __syncthreads();
            if (tid_() == 0) *(LAS int*)(lds + NSA_ITEM) = (int)atomicAdd(ctr, 1u);
            __syncthreads();
            const int it = *(LAS int*)(lds + NSA_ITEM);
            if (it >= 128 + T / 64) break;
            if (it < 128) nsa_compress_item(a, l, lds, it); else rwkv_prep_item(a, l, lds, it - 128);
        }
    }
}
DI void main_phase(KA a, const int l, LAS unsigned char* lds) {
    const int bx = blockIdx.x;
    for (int rep = 0; rep < REP_MAIN; ++rep) {
#if EN_GLA
    if (bx < 64) gla_item(a, l, lds, bx);
#ifdef REP_GLA
    if (bx < 64) gla_item(a, l, lds, bx);
#endif
#endif
#if EN_SCAN
    if (bx >= 64 && bx < 192) rwkv_scan2_item(a, lds, bx - 64);
#ifdef REP_SCAN
    if (bx >= 64 && bx < 192) rwkv_scan2_item(a, lds, bx - 64);
#endif
#endif
    nsa_main(a, l, lds, rep);
    }
}
DI void post_phase(KA a, const int l, LAS unsigned char* lds) {
#if EN_POST
    for (int rep = 0; rep < REP_PREP; ++rep)
    for (int tile = blockIdx.x; tile < T / 64; tile += gridDim.x) rwkv_post_item(a, l, lds, tile);
#endif
}

DI void main_phase_a(KA a, const int l, LAS unsigned char* lds) {
    const int bx = blockIdx.x;
    if (bx < 64) gla_item(a, l, lds, bx);
    if (bx >= 64 && bx < 192) rwkv_scan2_item(a, lds, bx - 64);
}
DI void main_phase_b(KA a, const int l, LAS unsigned char* lds) { nsa_main(a, l, lds, 0); }
__global__ void __launch_bounds__(NTHR, 2) fwd_megakernel(Args a_unused) {
    extern __shared__ __attribute__((aligned(16))) unsigned char lds_raw[];
    LAS unsigned char* lds = (LAS unsigned char*)lds_raw;
    cg::grid_group grid = cg::this_grid();
    { LAS unsigned* z = (LAS unsigned*)(lds + XB_LDS_OFF); if (tid_() < 4) z[tid_()] = 0u; }
    __syncthreads();
    if (blockIdx.x == 0) { unsigned* ctl = (unsigned*)(ARGS()->ws + WS_CTL); for (int i = tid_(); i < (int)(CTL_BYTES / 4); i += NTHR) ctl[i] = 0u; }
    { KA a = ARGS(); prologue(a, lds); }
#ifdef REP_PRO
    __syncthreads();
    { KA a = ARGS(); prologue(a, lds); }
#endif
    grid.sync();
    const XcdBarrier xbar = xcd_barrier_post((unsigned*)(ARGS()->ws + WS_CTL) + CW_BAR, (volatile LAS unsigned*)(lds + XB_LDS_OFF));
#ifdef EXTRA_SYNCS
    for (int i = 0; i < EXTRA_SYNCS; ++i) xcd_barrier(xbar);
#endif
#pragma unroll
    for (int l = 0; l < 2; ++l) {
        { KA a = ARGS(); unsigned char* ws = a->ws;
          pg8::Gemm g{(const bf16*)(ws + WS_ACT), (const bf16*)(ws + WS_WIN + l * WIN_STRIDE), T, HP, D}; pg8::StaticOrder S; S.init(T, HP, gridDim.x, blockIdx.x, WGM_IN);
          EpiH E{(bf16*)(ws + WS_H), HP}; pg8::gemm_phase<EpiH, pg8::StaticOrder, true, true>(lds, g, S, E);
#ifdef REP_GEMM
          pg8::gemm_phase<EpiH, pg8::StaticOrder, true, true>(lds, g, S, E);
#endif
        }
        xcd_barrier(xbar);
        { KA a = ARGS(); prep_phase(a, l, lds); }
        xcd_barrier(xbar);
#ifdef SPLIT_MAIN
        { KA a = ARGS(); main_phase_a(a, l, lds); }
        xcd_barrier(xbar);
        { KA a = ARGS(); main_phase_b(a, l, lds); }
#else
        { KA a = ARGS(); main_phase(a, l, lds); }
#endif
        xcd_barrier(xbar);
        { KA a = ARGS(); post_phase(a, l, lds); }
        xcd_barrier(xbar);
        { KA a = ARGS(); unsigned char* ws = a->ws;
          pg8::Gemm g{(const bf16*)(ws + WS_ACT), (const bf16*)(ws + WS_WOUT + l * WOUT_STRIDE), T, D, D}; pg8::StaticOrder S; S.init(T, D, gridDim.x, blockIdx.x, WGM_N1K);
          EpiRes E{l == 0 ? a->in[I_X] : a->out, a->out}; pg8::gemm_phase<EpiRes, pg8::StaticOrder, true, true>(lds, g, S, E); }
        xcd_barrier(xbar);
        { KA a = ARGS(); ln_phase(a->out, (bf16*)(a->ws + WS_ACT), a->in[I_LN1W] + l * D, a->in[I_LN1B] + l * D, false, true); }
        xcd_barrier(xbar);
        { KA a = ARGS(); unsigned char* ws = a->ws;
          pg8::Gemm g{(const bf16*)(ws + WS_ACT), (const bf16*)(ws + WS_WGU + l * WGU_STRIDE), T, FF2, D}; pg8::StaticOrder S; S.init(T, FF2, gridDim.x, blockIdx.x, WGM_F1);
          EpiSwiGLU E{(bf16*)(ws + WS_H)}; pg8::gemm_phase<EpiSwiGLU, pg8::StaticOrder, true, true>(lds, g, S, E);
#ifdef REP_GEMM
          pg8::gemm_phase<EpiSwiGLU, pg8::StaticOrder, true, true>(lds, g, S, E);
#endif
        }
        xcd_barrier(xbar);
        { KA a = ARGS(); unsigned char* ws = a->ws;
          pg8::Gemm g{(const bf16*)(ws + WS_H), (const bf16*)(ws + WS_WD + l * WD_STRIDE), T, D, FF}; pg8::StaticOrder S; S.init(T, D, gridDim.x, blockIdx.x, WGM_N1K);
          EpiResB E{(const bf16*)(ws + WS_ACT), a->out}; pg8::gemm_phase<EpiResB, pg8::StaticOrder, true, true>(lds, g, S, E); }
        xcd_barrier(xbar);
        { KA a = ARGS(); ln_phase(a->out, (bf16*)(a->ws + WS_ACT), a->in[I_LN2W] + l * D, a->in[I_LN2B] + l * D, true, l == 0); }
        if (l == 0) xcd_barrier(xbar);
    }
}

extern "C" void kernel_launch(void* const* d_in, const int* in_sizes, int n_in, void* d_out, int out_size, void* d_ws, size_t ws_size, hipStream_t stream) {
    static int grid = 0;
    if (grid == 0) {
        if (n_in != 35 || out_size != T * D || ws_size < WS_END) { fprintf(stderr, "kernel_launch: unexpected shapes (n_in %d out %d ws %zu)\n", n_in, out_size, ws_size); grid = -1; return; }
        int dev = 0, cus = 0, per_cu = 0;
        hipGetDevice(&dev); hipDeviceGetAttribute(&cus, hipDeviceAttributeMultiprocessorCount, dev);
        if (hipFuncSetAttribute((const void*)fwd_megakernel, hipFuncAttributeMaxDynamicSharedMemorySize, LDS_BYTES) != hipSuccess) { fprintf(stderr, "kernel_launch: hipFuncSetAttribute failed\n"); grid = -1; return; }
        if (hipOccupancyMaxActiveBlocksPerMultiprocessor(&per_cu, (const void*)fwd_megakernel, NTHR, LDS_BYTES) != hipSuccess || per_cu < 1) { fprintf(stderr, "kernel_launch: occupancy query says %d\n", per_cu); per_cu = 1; }
        (void)hipGetLastError();
        grid = cus;
    }
    if (grid < 0) return;
    Args a{};
    for (int i = 0; i < 35; ++i) a.in[i] = (const float*)d_in[i];
    a.out = (float*)d_out; a.ws = (unsigned char*)d_ws;
    void* args[] = {&a};
    hipError_t e = hipLaunchCooperativeKernel((const void*)fwd_megakernel, dim3(grid), dim3(NTHR), args, LDS_BYTES, stream);
    if (e != hipSuccess) fprintf(stderr, "cooperative launch failed: %s (grid %d)\n", hipGetErrorString(e), grid);
}
```
